# Optimizing an MI355X kernel written in HIP

```python
import math
import jax, jax.numpy as jnp
from jax import lax
import numpy as np

D_MODEL = 1024
BATCH = 2
SEQ = 8192
DEPTH = 2
DEC_BATCH = 8
DEC_SEQ = 2048
PAST_LEN = 128

N_MIXERS = 2
N_HEADS = 16
HEAD_DIM = D_MODEL // N_HEADS
N_KV_HEADS = 4
Q_PER_KV = N_HEADS // N_KV_HEADS
ROT_HALF = HEAD_DIM // 2
ROPE_THETA = 10000.0
Q_BLOCK = 128
GRID_W = 64
SGU_CHUNK = 128
SGU_INNER = 2 * D_MODEL
SGU_GROUPS = 8
SGU_GROUP_DIM = SGU_INNER // SGU_GROUPS
FFN_DIM = 2816
CONV_W = 3
EPS = 1e-6

kernel_name = "hybrid_attn_sgu_convffn_encoder"


def rmsnorm(x, g):
    xf = x.astype(jnp.float32)
    y = xf * lax.rsqrt(jnp.mean(xf * xf, axis=-1, keepdims=True) + EPS)
    return (y * g.astype(jnp.float32)).astype(x.dtype)


def rotate_half(y):
    a, b = jnp.split(y, 2, axis=-1)
    return jnp.concatenate([-b, a], axis=-1)


def axial_rope_tables(rows):
    row_idx = jnp.broadcast_to(jnp.arange(rows)[:, None], (rows, GRID_W)).reshape(-1)
    col_idx = jnp.broadcast_to(jnp.arange(GRID_W)[None, :], (rows, GRID_W)).reshape(-1)
    inv_freq = ROPE_THETA ** (-jnp.arange(0, ROT_HALF, 2, dtype=jnp.float32) / ROT_HALF)
    ang_r = row_idx.astype(jnp.float32)[:, None] * inv_freq[None, :]
    ang_c = col_idx.astype(jnp.float32)[:, None] * inv_freq[None, :]
    ang = jnp.concatenate([ang_r, ang_r, ang_c, ang_c], axis=-1)
    return jnp.cos(ang), jnp.sin(ang)


def apply_axial_rope(x, cos, sin):
    xf = x.astype(jnp.float32)
    xr = jnp.concatenate([rotate_half(xf[..., :ROT_HALF]), rotate_half(xf[..., ROT_HALF:])], axis=-1)
    out = xf * cos[None, :, None, :] + xr * sin[None, :, None, :]
    return out.astype(x.dtype)


def attention_mixer(x, w_qkv, q_gain, k_gain, w_o):
    B, T, _ = x.shape
    rows = T // GRID_W
    cos, sin = axial_rope_tables(rows)
    qkv = x @ w_qkv
    q = qkv[..., :N_HEADS * HEAD_DIM].reshape(B, T, N_HEADS, HEAD_DIM)
    k = qkv[..., N_HEADS * HEAD_DIM:(N_HEADS + N_KV_HEADS) * HEAD_DIM].reshape(B, T, N_KV_HEADS, HEAD_DIM)
    v = qkv[..., (N_HEADS + N_KV_HEADS) * HEAD_DIM:].reshape(B, T, N_KV_HEADS, HEAD_DIM)
    q = apply_axial_rope(rmsnorm(q, q_gain), cos, sin)
    k = apply_axial_rope(rmsnorm(k, k_gain), cos, sin)
    scale = 1.0 / math.sqrt(HEAD_DIM)
    nb = T // Q_BLOCK
    qb = q.reshape(B, nb, Q_BLOCK, N_KV_HEADS, Q_PER_KV, HEAD_DIM).transpose(1, 0, 2, 3, 4, 5)

    def block(qi):
        s = jnp.einsum('bqkgd,bskd->bkgqs', qi, k).astype(jnp.float32) * scale
        p = jax.nn.softmax(s, axis=-1).astype(v.dtype)
        return jnp.einsum('bkgqs,bskd->bqkgd', p, v)

    o = lax.map(block, qb)
    o = o.transpose(1, 0, 2, 3, 4, 5).reshape(B, T, N_HEADS * HEAD_DIM)
    return o @ w_o


def sgu_mixer(x, w_in, v_gain, w_s, b_s, w_out):
    B, T, _ = x.shape
    nc = T // SGU_CHUNK
    z = jax.nn.gelu(x @ w_in)
    u, v = jnp.split(z, 2, axis=-1)
    v = rmsnorm(v, v_gain)
    vc = v.reshape(B, nc, SGU_CHUNK, SGU_GROUPS, SGU_GROUP_DIM)
    s = jnp.einsum('gpq,bcqgd->bcpgd', w_s, vc) + b_s.T[None, None, :, :, None]
    y = u * s.reshape(B, T, SGU_INNER)
    return y @ w_out


def conv_ffn(x, w_up, conv_w, conv_b, w_down):
    h = x @ w_up
    hp = jnp.pad(h, ((0, 0), (1, 1), (0, 0)))
    h = hp[:, :-2] * conv_w[0] + hp[:, 1:-1] * conv_w[1] + hp[:, 2:] * conv_w[2] + conv_b
    gate, up = jnp.split(h, 2, axis=-1)
    return (jax.nn.silu(gate) * up) @ w_down


def trunk(x, norm_mix, norm_ffn, attn_w_qkv, attn_q_norm, attn_k_norm, attn_w_o,
          sgu_w_in, sgu_v_norm, sgu_w_s, sgu_b_s, sgu_w_out,
          ffn_w_up, ffn_conv_w, ffn_conv_b, ffn_w_down):
    for i in range(DEPTH):
        h = rmsnorm(x, norm_mix[i])
        j = i // N_MIXERS
        if i % N_MIXERS == 0:
            mix = attention_mixer(h, attn_w_qkv[j], attn_q_norm[j], attn_k_norm[j], attn_w_o[j])
        else:
            mix = sgu_mixer(h, sgu_w_in[j], sgu_v_norm[j], sgu_w_s[j], sgu_b_s[j], sgu_w_out[j])
        x = x + mix
        h = rmsnorm(x, norm_ffn[i])
        x = x + conv_ffn(h, ffn_w_up[i], ffn_conv_w[i], ffn_conv_b[i], ffn_w_down[i])
    return x


def setup_inputs(seed: int = 0) -> dict:
    key = jax.random.key(seed)
    ks = jax.random.split(key, 20)
    n_a = (DEPTH + N_MIXERS - 1) // N_MIXERS
    n_b = DEPTH // N_MIXERS
    f32 = jnp.float32

    def w(k, shape, fan_in):
        return jax.random.normal(k, shape, f32) * (fan_in ** -0.5)

    def gain(k, shape):
        return 1.0 + 0.02 * jax.random.normal(k, shape, f32)

    qkv_out = (N_HEADS + 2 * N_KV_HEADS) * HEAD_DIM
    return {
        "x_prompt": jax.random.normal(ks[0], (BATCH, SEQ, D_MODEL), f32),
        "x_sample": jax.random.normal(ks[1], (DEC_BATCH, DEC_SEQ, D_MODEL), f32),
        "norm_mix": gain(ks[2], (DEPTH, D_MODEL)),
        "norm_ffn": gain(ks[3], (DEPTH, D_MODEL)),
        "attn_w_qkv": w(ks[4], (n_a, D_MODEL, qkv_out), D_MODEL),
        "attn_q_norm": gain(ks[5], (n_a, HEAD_DIM)),
        "attn_k_norm": gain(ks[6], (n_a, HEAD_DIM)),
        "attn_w_o": w(ks[7], (n_a, N_HEADS * HEAD_DIM, D_MODEL), N_HEADS * HEAD_DIM),
        "sgu_w_in": w(ks[8], (n_b, D_MODEL, 2 * SGU_INNER), D_MODEL),
        "sgu_v_norm": gain(ks[9], (n_b, SGU_INNER)),
        "sgu_w_s": w(ks[10], (n_b, SGU_GROUPS, SGU_CHUNK, SGU_CHUNK), SGU_CHUNK),
        "sgu_b_s": gain(ks[11], (n_b, SGU_GROUPS, SGU_CHUNK)),
        "sgu_w_out": w(ks[12], (n_b, SGU_INNER, D_MODEL), SGU_INNER),
        "ffn_w_up": w(ks[13], (DEPTH, D_MODEL, 2 * FFN_DIM), D_MODEL),
        "ffn_conv_w": w(ks[14], (DEPTH, CONV_W, 2 * FFN_DIM), CONV_W),
        "ffn_conv_b": 0.02 * jax.random.normal(ks[15], (DEPTH, 2 * FFN_DIM), f32),
        "ffn_w_down": w(ks[16], (DEPTH, FFN_DIM, D_MODEL), FFN_DIM),
    }


def reference(x_prompt, x_sample, norm_mix, norm_ffn, attn_w_qkv, attn_q_norm, attn_k_norm, attn_w_o,
              sgu_w_in, sgu_v_norm, sgu_w_s, sgu_b_s, sgu_w_out,
              ffn_w_up, ffn_conv_w, ffn_conv_b, ffn_w_down):
    y_prompt = trunk(x_prompt, norm_mix, norm_ffn, attn_w_qkv, attn_q_norm, attn_k_norm, attn_w_o,
                     sgu_w_in, sgu_v_norm, sgu_w_s, sgu_b_s, sgu_w_out,
                     ffn_w_up, ffn_conv_w, ffn_conv_b, ffn_w_down)
    y_sample = trunk(x_sample, norm_mix, norm_ffn, attn_w_qkv, attn_q_norm, attn_k_norm, attn_w_o,
                     sgu_w_in, sgu_v_norm, sgu_w_s, sgu_b_s, sgu_w_out,
                     ffn_w_up, ffn_conv_w, ffn_conv_b, ffn_w_down)
    return (y_prompt, y_sample)
```

```cpp
#include <hip/hip_runtime.h>
#include <hip/hip_cooperative_groups.h>
namespace cg = cooperative_groups;
#include <cstdio>
#include <cstdint>
namespace pg8 {
#define PG8_LAS __attribute__((address_space(3)))
typedef unsigned short bf16_t;
typedef short bf16x8 __attribute__((ext_vector_type(8)));
typedef float f32x4 __attribute__((ext_vector_type(4)));
typedef unsigned u32x4 __attribute__((ext_vector_type(4)));
constexpr int BM = 256, BK = 64, HALF = 128, HTB = HALF * BK * 2  , STAGE_BYTES = 8 * HTB, NXCD = 8, WGM = 8;

__host__ __device__ __forceinline__ int lds_byte(int r, int c) { const int st = (r >> 4) * 2 + (c >> 5), rr = r & 15, cc = c & 31, ob = rr * 64 + cc * 2; return st * 1024 + (ob ^ (((ob >> 9) & 1) << 5)); }
__host__ __device__ __forceinline__ void stage_rc(int b, int& R, int& C) { const int st = b / 1024, sb = b % 1024, swz = sb ^ (((sb >> 9) & 1) << 5); R = (st >> 1) * 16 + swz / 64; C = (st & 1) * 32 + (swz % 64) / 2; }
__host__ __device__ __forceinline__ int perm32(int rho) { const int n = rho >> 4, i = rho & 15; return 8 * (i >> 2) + 4 * n + (i & 3); }

struct Unit { int pm, pn; };
struct Gemm { const bf16_t* A; const bf16_t* Bt; int M, N, K, lda, ldb; };

struct StaticOrder {
    int nM, nN, nwg, G, c, rot;
    __host__ __device__ __forceinline__ void init(int M, int N, int G_, int c_) { nM = M / BM; nN = N / BM; nwg = nM * nN; G = G_; c = c_;
        const bool whole = (G % NXCD == 0) && (nwg % NXCD == 0) && (nM % WGM == 0) && ((nwg / NXCD) % (WGM * nN) == 0);
        rot = whole ? (c % NXCD) * ((nN + NXCD - 1) / NXCD) : 0; }
    __host__ __device__ __forceinline__ bool next(int i, Unit& u) const {
        const long L = (long)i * G + c; if (L >= nwg) return false;
        int wgid = (int)L; { const int q = nwg / NXCD, r = nwg % NXCD, xcd = wgid % NXCD, off = wgid / NXCD; wgid = (xcd < r ? xcd * (q + 1) : r * (q + 1) + (xcd - r) * q) + off; }
        const int nig = WGM * nN, gid = wgid / nig, fm = gid * WGM, gsz = (nM - fm) < WGM ? (nM - fm) : WGM;
        u.pm = fm + ((wgid % nig) % gsz); u.pn = ((wgid % nig) / gsz + rot) % nN; return true;
    }
    __device__ __forceinline__ void a_ready(const Unit&) const {}
    __device__ __forceinline__ void done(const Unit&) const {}
};

__device__ __forceinline__ unsigned cvt_pk_bf16(float lo, float hi) { unsigned r; asm volatile("v_cvt_pk_bf16_f32 %0, %1, %2" : "=v"(r) : "v"(lo), "v"(hi)); return r; }
typedef float f32x2 __attribute__((ext_vector_type(2)));
__device__ __forceinline__ float gelu_tanh(float x) { const float u = x * x * 0.044715f + 1.0f; const float e = __builtin_amdgcn_exp2f(-2.302208198f * x * u); return x * __builtin_amdgcn_rcpf(1.0f + e); }

template <int ACT> struct EpiBf16S {
    static constexpr bool PERM = true, AFTER_DRAIN = false, ROWPERM = false; static constexpr int NPARAM = 0;
    bf16_t* O; int ldc; const float* rstat; float rdim_inv; int row_off; float* vstat; int vcol0;
    __device__ __forceinline__ void operator()(const f32x4 (&acc)[2][2][4][2], const Unit& u, int wr, int wc, int fr, int fq, PG8_LAS unsigned char* pbuf) const {
        const int row0 = u.pm * BM + wr * 64 + fr, col0 = u.pn * BM + wc * 32 + 8 * fq;
        const bool dov = (vstat != nullptr) && (u.pn * BM >= vcol0);
        float ssv[2][4] = {{0.f, 0.f, 0.f, 0.f}, {0.f, 0.f, 0.f, 0.f}};
#pragma unroll
        for (int ai = 0; ai < 2; ++ai)
#pragma unroll
            for (int m = 0; m < 4; ++m) {
                const int r = row0 + ai * HALF + m * 16;
                float sc = 1.f; if (rstat) sc = __builtin_amdgcn_rsqf(rstat[row_off + r] * rdim_inv + 1e-6f);
                bf16_t* rowp = O + (size_t)r * ldc + col0; float ss = 0.f;
#pragma unroll
                for (int bj = 0; bj < 2; ++bj) { f32x4 v0 = acc[ai][bj][m][0] * sc, v1 = acc[ai][bj][m][1] * sc;
                    if (ACT == 2) {
#pragma unroll
                        for (int j = 0; j < 4; ++j) { v0[j] = gelu_tanh(v0[j]); v1[j] = gelu_tanh(v1[j]); } }
                    ss += (v0[0] * v0[0] + v0[1] * v0[1]) + (v0[2] * v0[2] + v0[3] * v0[3]) + (v1[0] * v1[0] + v1[1] * v1[1]) + (v1[2] * v1[2] + v1[3] * v1[3]);
                    u32x4 w; w.x = cvt_pk_bf16(v0[0], v0[1]); w.y = cvt_pk_bf16(v0[2], v0[3]); w.z = cvt_pk_bf16(v1[0], v1[1]); w.w = cvt_pk_bf16(v1[2], v1[3]);
                    *(u32x4*)(rowp + bj * HALF) = w; }
                if (dov) { ss += __shfl_xor(ss, 16); ss += __shfl_xor(ss, 32); ssv[ai][m] = ss; }
            }
        if (dov) {
#pragma unroll
            for (int ai = 0; ai < 2; ++ai) { const float v = (fq == 0) ? ssv[ai][0] : (fq == 1) ? ssv[ai][1] : (fq == 2) ? ssv[ai][2] : ssv[ai][3];
                atomicAdd(vstat + row_off + u.pm * BM + ai * HALF + wr * 64 + 16 * fq + fr, v); }
        }
    }
};

struct EpiRes {
    static constexpr int NPARAM = 0;
    static constexpr bool PERM = true, AFTER_DRAIN = false, ROWPERM = false;
    const float* base0; const float* base1; int split_row; float* out; bf16_t* xn; float* stat; int row_off; const bf16_t* bbase;
    __device__ __forceinline__ void operator()(const f32x4 (&acc)[2][2][4][2], const Unit& u, int wr, int wc, int fr, int fq, PG8_LAS unsigned char* pbuf) const {
        const int col0 = u.pn * BM + wc * 32 + 8 * fq;
        float ssv[2][4];
#pragma unroll
        for (int ai = 0; ai < 2; ++ai)
#pragma unroll
            for (int m = 0; m < 4; ++m) {
                const int r = row_off + u.pm * BM + ai * HALF + wr * 64 + m * 16 + fr;
                const float* b = (r < split_row) ? base0 + (size_t)r * 1024 : base1 + (size_t)(r - split_row) * 1024;
                float* o = out + (size_t)r * 1024; float ss = 0.f;
#pragma unroll
                for (int bj = 0; bj < 2; ++bj) { const int c = col0 + bj * HALF;
                    f32x4 b0, b1;
                    if (bbase) { const u32x4 w = *(const u32x4*)(bbase + (size_t)r * 1024 + c);
                        b0 = (f32x4){__builtin_bit_cast(float, w.x << 16), __builtin_bit_cast(float, w.x & 0xffff0000u), __builtin_bit_cast(float, w.y << 16), __builtin_bit_cast(float, w.y & 0xffff0000u)};
                        b1 = (f32x4){__builtin_bit_cast(float, w.z << 16), __builtin_bit_cast(float, w.z & 0xffff0000u), __builtin_bit_cast(float, w.w << 16), __builtin_bit_cast(float, w.w & 0xffff0000u)}; }
                    else { b0 = *(const f32x4*)(b + c); b1 = *(const f32x4*)(b + c + 4); }
                    const f32x4 x0 = b0 + acc[ai][bj][m][0], x1 = b1 + acc[ai][bj][m][1];
                    if (out) { *(f32x4*)(o + c) = x0; *(f32x4*)(o + c + 4) = x1; }
                    ss += (x0[0] * x0[0] + x0[1] * x0[1]) + (x0[2] * x0[2] + x0[3] * x0[3]) + (x1[0] * x1[0] + x1[1] * x1[1]) + (x1[2] * x1[2] + x1[3] * x1[3]);
                    if (xn) { u32x4 w; w.x = cvt_pk_bf16(x0[0], x0[1]); w.y = cvt_pk_bf16(x0[2], x0[3]); w.z = cvt_pk_bf16(x1[0], x1[1]); w.w = cvt_pk_bf16(x1[2], x1[3]); *(u32x4*)(xn + (size_t)r * 1024 + c) = w; } }
                ss += __shfl_xor(ss, 16); ss += __shfl_xor(ss, 32); ssv[ai][m] = ss;
                asm volatile("" ::: "memory");
            }
        if (stat) {
#pragma unroll
            for (int ai = 0; ai < 2; ++ai) { const float v = (fq == 0) ? ssv[ai][0] : (fq == 1) ? ssv[ai][1] : (fq == 2) ? ssv[ai][2] : ssv[ai][3];
                atomicAdd(stat + row_off + u.pm * BM + ai * HALF + wr * 64 + 16 * fq + fr, v); }
        }
    }
};

struct EpiResF {
    static constexpr bool PERM = false, AFTER_DRAIN = false, ROWPERM = false; static constexpr int NPARAM = 0;
    const float* base0; const float* base1; int split_row; float* out; bf16_t* xn; float* stat; int row_off; const bf16_t* bbase;
    __device__ __forceinline__ void operator()(const f32x4 (&acc)[2][2][4][2], const Unit& u, int wr, int wc, int fr, int fq, PG8_LAS unsigned char* pbuf) const {
        const int col0 = u.pn * BM + wc * 32 + 4 * fq;
#pragma unroll
        for (int ai = 0; ai < 2; ++ai)
#pragma unroll
            for (int m = 0; m < 4; ++m) {
                const int r = row_off + u.pm * BM + ai * HALF + wr * 64 + m * 16 + fr;
                const float* b = (r < split_row) ? base0 + (size_t)r * 1024 : base1 + (size_t)(r - split_row) * 1024;
                float* o = out + (size_t)r * 1024; float ss = 0.f;
#pragma unroll
                for (int bj = 0; bj < 2; ++bj)
#pragma unroll
                    for (int n = 0; n < 2; ++n) { const int c = col0 + bj * HALF + n * 16;
                        f32x4 bs;
                        if (bbase) { typedef unsigned u32x2w __attribute__((ext_vector_type(2))); const u32x2w w = *(const u32x2w*)(bbase + (size_t)r * 1024 + c);
                            bs = (f32x4){__builtin_bit_cast(float, w.x << 16), __builtin_bit_cast(float, w.x & 0xffff0000u), __builtin_bit_cast(float, w.y << 16), __builtin_bit_cast(float, w.y & 0xffff0000u)}; }
                        else bs = *(const f32x4*)(b + c);
                        const f32x4 x = bs + acc[ai][bj][m][n]; if (out) *(f32x4*)(o + c) = x;
                        ss += (x[0] * x[0] + x[1] * x[1]) + (x[2] * x[2] + x[3] * x[3]);
                        if (xn) { typedef unsigned u32x2v __attribute__((ext_vector_type(2))); u32x2v w; w.x = cvt_pk_bf16(x[0], x[1]); w.y = cvt_pk_bf16(x[2], x[3]); *(u32x2v*)(xn + (size_t)r * 1024 + c) = w; } }
                if (stat) { ss += __shfl_xor(ss, 16); ss += __shfl_xor(ss, 32); if (fq == 0) atomicAdd(stat + r, ss); }
                asm volatile("" ::: "memory");
            }
    }
};

__device__ __forceinline__ float dpp_shr1(float x) { return __builtin_bit_cast(float, __builtin_amdgcn_mov_dpp(__builtin_bit_cast(int, x), 0x111, 0xf, 0xf, true)); }
__device__ __forceinline__ float dpp_shl1(float x) { return __builtin_bit_cast(float, __builtin_amdgcn_mov_dpp(__builtin_bit_cast(int, x), 0x101, 0xf, 0xf, true)); }
__device__ __forceinline__ float dpp_ror1(float x)  { return __builtin_bit_cast(float, __builtin_amdgcn_mov_dpp(__builtin_bit_cast(int, x), 0x121, 0xf, 0xf, true)); }
__device__ __forceinline__ float dpp_ror15(float x) { return __builtin_bit_cast(float, __builtin_amdgcn_mov_dpp(__builtin_bit_cast(int, x), 0x12F, 0xf, 0xf, true)); }
struct EpiConv {
    static constexpr bool PERM = true, AFTER_DRAIN = false, ROWPERM = true;
    static constexpr int NPARAM = 1;
    bf16_t* ACT; bf16_t* HALO; const float* rstat; int row_off; const float* cw; const float* cb;
    __device__ __forceinline__ void stage_params(const Unit& u, PG8_LAS unsigned char* pbuf, int wr, int wc, int lane) const {
        asm volatile("" : "+v"(lane));
        const int cbase = u.pn * 128 + wc * 32;
        { const float* gp;
          if (lane < 32) gp = rstat + row_off + u.pm * BM + (lane >> 4) * HALF + wr * 64 + 4 * (lane & 15);
          else { const int j = lane - 32; gp = cw + (j >> 4) * 5632 + ((j >> 3) & 1) * 2816 + cbase + 4 * (j & 7); }
          __builtin_amdgcn_global_load_lds((const unsigned*)gp, (PG8_LAS unsigned*)pbuf, 16, 0, 0); }
        if (lane < 32) { const int j = lane; const float* gp = ((j >> 4) ? cb : cw + 2 * 5632) + ((j >> 3) & 1) * 2816 + cbase + 4 * (j & 7);
          __builtin_amdgcn_global_load_lds((const unsigned*)gp, (PG8_LAS unsigned*)(pbuf + 1024), 16, 0, 0); }
    }
    __device__ __forceinline__ void operator()(const f32x4 (&acc)[2][2][4][2], const Unit& u, int wr, int wc, int fr, int fq, PG8_LAS unsigned char* pbuf) const {
        const int a0 = u.pn * 128 + wc * 32 + 8 * fq, ng0 = u.pn * 256 + wc * 32 + 8 * fq;
        f32x4 wgA[2][3], wuA[2][3], bgA[2], buA[2], s4A[2];
#pragma unroll
        for (int ai = 0; ai < 2; ++ai) s4A[ai] = *(const PG8_LAS f32x4*)(pbuf + (ai * 64 + 4 * fr) * 4);
#pragma unroll
        for (int n = 0; n < 2; ++n) { const int cg4 = (2 * fq + n) * 16;
#pragma unroll
            for (int k = 0; k < 2; ++k) { wgA[n][k] = *(const PG8_LAS f32x4*)(pbuf + 512 + k * 256 + cg4); wuA[n][k] = *(const PG8_LAS f32x4*)(pbuf + 512 + k * 256 + 128 + cg4); }
            wgA[n][2] = *(const PG8_LAS f32x4*)(pbuf + 1024 + cg4); wuA[n][2] = *(const PG8_LAS f32x4*)(pbuf + 1024 + 128 + cg4);
            bgA[n] = *(const PG8_LAS f32x4*)(pbuf + 1280 + cg4); buA[n] = *(const PG8_LAS f32x4*)(pbuf + 1280 + 128 + cg4); }
#pragma unroll
        for (int ai = 0; ai < 2; ++ai) {
            const int R0 = u.pm * BM + ai * HALF + wr * 64;
            float sc[4];
            { const f32x4 s4 = s4A[ai];
#pragma unroll
              for (int m = 0; m < 4; ++m) sc[m] = __builtin_amdgcn_rsqf(s4[m] * (1.0f / 1024.0f) + 1e-6f); }
            if (fr == 0 || fr == 15) { bf16_t* hb = HALO + (size_t)(R0 >> 6) * 4 * 5632 + ng0;
#pragma unroll
              for (int bj = 0; bj < 2; ++bj)
#pragma unroll
                  for (int m = 0; m < 4; ++m) { const bool mine = (fr == 0) ? (m < 2) : (m >= 2);
                      if (mine) { const f32x4 v0 = acc[ai][bj][m][0] * sc[m], v1 = acc[ai][bj][m][1] * sc[m];
                          u32x4 w; w.x = cvt_pk_bf16(v0[0], v0[1]); w.y = cvt_pk_bf16(v0[2], v0[3]); w.z = cvt_pk_bf16(v1[0], v1[1]); w.w = cvt_pk_bf16(v1[2], v1[3]);
                          *(u32x4*)(hb + (size_t)m * 5632 + bj * HALF) = w; } } }
            unsigned ow[4][4];
#pragma unroll
            for (int n = 0; n < 2; ++n) {
                const f32x4 (&wg)[3] = wgA[n]; const f32x4 (&wu)[3] = wuA[n]; const f32x4 bg = bgA[n], bu = buA[n];
                float keep[4];
#pragma unroll
                for (int j = 0; j < 4; ++j) {
                    float xg[6], xu[6];
#pragma unroll
                    for (int m = 0; m < 4; ++m) { xg[m + 1] = acc[ai][0][m][n][j] * sc[m]; xu[m + 1] = acc[ai][1][m][n][j] * sc[m]; }
                    xg[0] = dpp_shr1(xg[4]); xg[5] = dpp_shl1(xg[1]); xu[0] = dpp_shr1(xu[4]); xu[5] = dpp_shl1(xu[1]);
#pragma unroll
                    for (int m = 0; m < 4; ++m) {
                        const float g = xg[m] * wg[0][j] + xg[m + 1] * wg[1][j] + xg[m + 2] * wg[2][j] + bg[j];
                        const float uu = xu[m] * wu[0][j] + xu[m + 1] * wu[1][j] + xu[m + 2] * wu[2][j] + bu[j];
                        const float av = g * __builtin_amdgcn_rcpf(1.0f + __builtin_amdgcn_exp2f(-1.4426950408889634f * g)) * uu;
                        if (j & 1) ow[m][2 * n + (j >> 1)] = cvt_pk_bf16(keep[m], av); else keep[m] = av;
                    }
                    __builtin_amdgcn_sched_barrier(0);
                }
            }
#pragma unroll
            for (int m = 0; m < 4; ++m) {
                u32x4 w; w.x = ow[m][0]; w.y = ow[m][1]; w.z = ow[m][2]; w.w = ow[m][3];
                const bool edge = (m == 0 && fr == 0) || (m == 3 && fr == 15);
                if (!edge) *(u32x4*)(ACT + (size_t)(R0 + 4 * fr + m) * 2816 + a0) = w;
            }
            asm volatile("" ::: "memory");
        }
    }
};

struct EpiQKV {
    static constexpr bool PERM = false, AFTER_DRAIN = false, ROWPERM = false; static constexpr int NPARAM = 0;
    bf16_t* O; const float* rstat; const float* qg; const float* kg;
    __device__ __forceinline__ void operator()(const f32x4 (&acc)[2][2][4][2], const Unit& u, int wr, int wc, int fr, int fq, PG8_LAS unsigned char* pbuf) const {
        typedef unsigned u32x2v __attribute__((ext_vector_type(2)));
        if (u.pn == 5) {
            const int col0 = 1280 + wc * 32 + 4 * fq;
#pragma unroll
            for (int ai = 0; ai < 2; ++ai)
#pragma unroll
                for (int m = 0; m < 4; ++m) { const int r = u.pm * BM + ai * HALF + wr * 64 + m * 16 + fr; const float sc = __builtin_amdgcn_rsqf(rstat[r] * (1.0f / 1024.0f) + 1e-6f);
#pragma unroll
                    for (int bj = 0; bj < 2; ++bj)
#pragma unroll
                        for (int n = 0; n < 2; ++n) { const f32x4 v = acc[ai][bj][m][n] * sc; u32x2v w; w.x = cvt_pk_bf16(v[0], v[1]); w.y = cvt_pk_bf16(v[2], v[3]);
                            *(u32x2v*)(O + (size_t)r * 1536 + col0 + bj * HALF + n * 16) = w; } }
            return;
        }
        const int head = u.pn * 4 + wc; const bool isq = u.pn < 4; const float* gp = isq ? qg : kg;
        f32x4 gn[2][2];
#pragma unroll
        for (int bj = 0; bj < 2; ++bj)
#pragma unroll
            for (int n = 0; n < 2; ++n) gn[bj][n] = *(const f32x4*)(gp + 32 * bj + 16 * n + 4 * fq);
        float invf[4];
#pragma unroll
        for (int j = 0; j < 4; ++j) invf[j] = __builtin_amdgcn_exp2f(-(float)(4 * fq + j) * 0.830482024f) * 0.15915494309189535f;
        const float osc = isq ? 0.125f * 1.4426950408889634f : 1.0f;
#pragma unroll
        for (int ai = 0; ai < 2; ++ai)
#pragma unroll
            for (int m = 0; m < 4; ++m) {
                const int r = u.pm * BM + ai * HALF + wr * 64 + m * 16 + fr; const float sc = __builtin_amdgcn_rsqf(rstat[r] * (1.0f / 1024.0f) + 1e-6f);
                f32x4 q[2][2]; float ss = 0.f;
#pragma unroll
                for (int bj = 0; bj < 2; ++bj)
#pragma unroll
                    for (int n = 0; n < 2; ++n) { q[bj][n] = acc[ai][bj][m][n] * sc; const f32x4 x = q[bj][n]; ss += (x[0] * x[0] + x[1] * x[1]) + (x[2] * x[2] + x[3] * x[3]); }
                ss += __shfl_xor(ss, 16); ss += __shfl_xor(ss, 32);
                const float rn = __builtin_amdgcn_rsqf(ss * (1.0f / 64.0f) + 1e-6f);
                const int t = (r < 16384) ? (r & 8191) : (r & 2047);
                bf16_t* op = O + (size_t)r * 1536 + head * 64 + 4 * fq;
#pragma unroll
                for (int bj = 0; bj < 2; ++bj) {
                    float pos = (float)(bj ? (t & 63) : (t >> 6)); asm volatile("" : "+v"(pos));
                    float oa[4], ob[4];
#pragma unroll
                    for (int j = 0; j < 4; ++j) {
                        float rev = pos * invf[j]; rev -= __builtin_floorf(rev);
                        const float sn = __builtin_amdgcn_sinf(rev), cs = __builtin_amdgcn_cosf(rev);
                        const float a = q[bj][0][j] * rn * gn[bj][0][j], b = q[bj][1][j] * rn * gn[bj][1][j];
                        oa[j] = (a * cs - b * sn) * osc; ob[j] = (b * cs + a * sn) * osc;
                    }
                    u32x2v wa, wb; wa.x = cvt_pk_bf16(oa[0], oa[1]); wa.y = cvt_pk_bf16(oa[2], oa[3]); wb.x = cvt_pk_bf16(ob[0], ob[1]); wb.y = cvt_pk_bf16(ob[2], ob[3]);
                    *(u32x2v*)(op + 32 * bj) = wa; *(u32x2v*)(op + 32 * bj + 16) = wb;
                    __builtin_amdgcn_sched_barrier(0);
                }
            }
    }
};
template <class Epi, class Sched, bool ALIGN_EPI = false, bool SP2 = false>
__device__ __forceinline__ void gemm_phase(PG8_LAS unsigned char* lds, Gemm g, const Sched& S, const Epi& E) {
    int tid_ = threadIdx.x; asm volatile("" : "+v"(tid_));
    asm volatile("" : "+s"(g.A), "+s"(g.Bt));
    const int tid = tid_, wid = __builtin_amdgcn_readfirstlane(tid >> 6), lane = tid & 63, wr = wid >> 2, wc = wid & 3, fr = lane & 15, fq = lane >> 4;
    const int K = g.K, nt = K / BK;
    unsigned voffA[2], voffB[2];
#pragma unroll
    for (int i = 0; i < 2; ++i) { int R, C; stage_rc(tid * 16 + i * 8192, R, C); const int Rb = Epi::PERM ? ((R & ~31) + perm32(R & 31)) : R;
        const int Ra = Epi::ROWPERM ? ((R & ~63) + 4 * (R & 15) + ((R >> 4) & 3)) : R;
        voffA[i] = (unsigned)(Ra * g.lda + C) * 2u; voffB[i] = (unsigned)(Rb * g.ldb + C) * 2u; }
    const size_t kstep = (size_t)(BK * 2);
    const size_t hstepA = (size_t)HALF * g.lda * 2, hstepB = (size_t)HALF * g.ldb * 2;
    const size_t tstepA = 2 * hstepA, tstepB = 2 * hstepB;
    const unsigned ldsw = (unsigned)wid * 1024u;
    const int aoff = lds_byte(wr * 64 + fr, fq * 8), boff = lds_byte(wc * 32 + fr, fq * 8);
#define PG8_SA(b, h) (((b) * 2 + (h)) * HTB)
#define PG8_SB(b, h) ((4 + (b) * 2 + (h)) * HTB)
#define PG8_STAGE(bufoff, gbase, voff) do { _Pragma("unroll") for (int _i = 0; _i < 2; ++_i) \
        __builtin_amdgcn_global_load_lds((const unsigned*)((const char*)(gbase) + (voff)[_i]), (PG8_LAS unsigned*)(lds + (bufoff) + ldsw + _i * 8192), 16, 0, 0); } while (0)
#define PG8_LDA(dst, b, h) do { _Pragma("unroll") for (int m = 0; m < 4; ++m) _Pragma("unroll") for (int k = 0; k < 2; ++k) dst[m][k] = *(const PG8_LAS bf16x8*)(lds + PG8_SA(b, h) + aoff + m * 2048 + k * 1024); } while (0)
#define PG8_LDB(dst, b, h) do { _Pragma("unroll") for (int n = 0; n < 2; ++n) _Pragma("unroll") for (int k = 0; k < 2; ++k) dst[n][k] = *(const PG8_LAS bf16x8*)(lds + PG8_SB(b, h) + boff + n * 2048 + k * 1024); } while (0)
#define PG8_MMA(ai, bj, At, Bt) do { __builtin_amdgcn_s_setprio(1); _Pragma("unroll") for (int m = 0; m < 4; ++m) _Pragma("unroll") for (int n = 0; n < 2; ++n) _Pragma("unroll") for (int k = 0; k < 2; ++k) \
        acc[ai][bj][m][n] = __builtin_amdgcn_mfma_f32_16x16x32_bf16(Bt[n][k], At[m][k], acc[ai][bj][m][n], 0, 0, 0); __builtin_amdgcn_s_setprio(0); } while (0)
#define PG8_WAIT_V(n) asm volatile("s_waitcnt vmcnt(" #n ")" ::: "memory")
#define PG8_WAIT_L(n) asm volatile("s_waitcnt lgkmcnt(" #n ")" ::: "memory")
#define PG8_BAR __builtin_amdgcn_s_barrier()
#define PG8_SCHED __builtin_amdgcn_sched_barrier(0)
    Unit cur, nxt; int ui = 0;
    constexpr int PBLK_OFF = STAGE_BYTES + 1024, PBLK_WAVE = 1536, PBLK_ALL = 8 * PBLK_WAVE;
    PG8_LAS unsigned char* const pblk = lds + PBLK_OFF + wid * PBLK_WAVE; int upar = 0;
    if (!S.next(0, cur)) return;
    f32x4 acc[2][2][4][2];
#pragma unroll
    for (int a = 0; a < 2; ++a)
#pragma unroll
        for (int b = 0; b < 2; ++b)
#pragma unroll
            for (int m = 0; m < 4; ++m)
#pragma unroll
                for (int n = 0; n < 2; ++n) acc[a][b][m][n] = (f32x4){0.f, 0.f, 0.f, 0.f};
    bf16x8 At[4][2], B0[2][2], B1[2][2];
    const char* cA = (const char*)g.A + (size_t)cur.pm * tstepA; const char* cB = (const char*)g.Bt + (size_t)cur.pn * tstepB;
    S.a_ready(cur);
    if constexpr (Epi::NPARAM > 0) E.stage_params(cur, pblk, wr, wc, lane);
    if constexpr (SP2) {
        PG8_STAGE(PG8_SB(0, 0), cB, voffB); PG8_STAGE(PG8_SB(0, 1), cB + hstepB, voffB); PG8_STAGE(PG8_SA(0, 0), cA, voffA); PG8_STAGE(PG8_SA(0, 1), cA + hstepA, voffA);
        if (wr == 1) PG8_BAR;
        PG8_WAIT_V(2); PG8_BAR;
        PG8_STAGE(PG8_SB(1, 0), cB + kstep, voffB); PG8_STAGE(PG8_SA(1, 0), cA + kstep, voffA); PG8_STAGE(PG8_SB(1, 1), cB + hstepB + kstep, voffB);
        PG8_WAIT_V(6); PG8_BAR;
    } else {
        PG8_STAGE(PG8_SB(0, 0), cB, voffB); PG8_STAGE(PG8_SA(0, 0), cA, voffA); PG8_STAGE(PG8_SB(0, 1), cB + hstepB, voffB); PG8_STAGE(PG8_SA(0, 1), cA + hstepA, voffA);
        if (wr == 1) PG8_BAR;
        PG8_WAIT_V(4); PG8_BAR;
        PG8_STAGE(PG8_SB(1, 0), cB + kstep, voffB); PG8_STAGE(PG8_SA(1, 0), cA + kstep, voffA); PG8_STAGE(PG8_SB(1, 1), cB + hstepB + kstep, voffB);
        PG8_WAIT_V(6); PG8_BAR;
    }
    for (;;) {
        const bool has_next = S.next(ui + 1, nxt);
        const char* nA = has_next ? (const char*)g.A + (size_t)nxt.pm * tstepA : cA; const char* nB = has_next ? (const char*)g.Bt + (size_t)nxt.pn * tstepB : cB;
        for (int t = 0; t < nt; t += 2) {
            const bool last = (t == nt - 2);
            const char* a1 = cA + (size_t)(t + 1) * kstep;
            const char* a2 = last ? nA : cA + (size_t)(t + 2) * kstep; const char* b2 = last ? nB : cB + (size_t)(t + 2) * kstep;
            const char* a3 = a2 + kstep; const char* b3 = b2 + kstep;
            if (last && has_next) S.a_ready(nxt);
            if constexpr (SP2) {
            PG8_LDB(B0, 0, 0); PG8_LDB(B1, 0, 1); PG8_SCHED; PG8_LDA(At, 0, 0); PG8_STAGE(PG8_SA(1, 1), a1 + hstepA, voffA);
            PG8_WAIT_V(8); PG8_WAIT_L(0); PG8_BAR; PG8_MMA(0, 0, At, B0); PG8_MMA(0, 1, At, B1); PG8_BAR; PG8_SCHED;
            PG8_LDA(At, 0, 1); PG8_STAGE(PG8_SB(0, 0), b2, voffB); PG8_STAGE(PG8_SB(0, 1), b2 + hstepB, voffB); PG8_STAGE(PG8_SA(0, 0), a2, voffA);
            PG8_WAIT_V(8); PG8_WAIT_L(0); PG8_BAR; PG8_MMA(1, 0, At, B0); PG8_MMA(1, 1, At, B1); PG8_BAR; PG8_SCHED;
            PG8_LDB(B0, 1, 0); PG8_LDB(B1, 1, 1); PG8_SCHED; PG8_LDA(At, 1, 0); PG8_STAGE(PG8_SA(0, 1), a2 + hstepA, voffA);
            PG8_WAIT_V(8); PG8_WAIT_L(0); PG8_BAR; PG8_MMA(0, 0, At, B0); PG8_MMA(0, 1, At, B1); PG8_BAR; PG8_SCHED;
            PG8_LDA(At, 1, 1); PG8_STAGE(PG8_SB(1, 0), b3, voffB); PG8_STAGE(PG8_SB(1, 1), b3 + hstepB, voffB); PG8_STAGE(PG8_SA(1, 0), a3, voffA);
            PG8_WAIT_V(8); PG8_WAIT_L(0); PG8_BAR; PG8_MMA(1, 0, At, B0); PG8_MMA(1, 1, At, B1); PG8_BAR; PG8_SCHED;
            } else {
            PG8_LDB(B0, 0, 0); PG8_SCHED; PG8_LDA(At, 0, 0); PG8_STAGE(PG8_SA(1, 1), a1 + hstepA, voffA);
            PG8_WAIT_L(8); PG8_BAR; PG8_WAIT_L(0); PG8_MMA(0, 0, At, B0); PG8_BAR; PG8_SCHED;
            PG8_LDB(B1, 0, 1); PG8_STAGE(PG8_SB(0, 0), b2, voffB);
            PG8_BAR; PG8_WAIT_L(0); PG8_MMA(0, 1, At, B1); PG8_BAR;
            PG8_LDA(At, 0, 1); PG8_STAGE(PG8_SA(0, 0), a2, voffA);
            PG8_BAR; PG8_WAIT_L(0); PG8_MMA(1, 0, At, B0); PG8_BAR; PG8_SCHED;
            PG8_STAGE(PG8_SB(0, 1), b2 + hstepB, voffB);
            PG8_WAIT_V(6); PG8_BAR; PG8_MMA(1, 1, At, B1); PG8_BAR;
            PG8_LDB(B0, 1, 0); PG8_SCHED; PG8_LDA(At, 1, 0); PG8_STAGE(PG8_SA(0, 1), a2 + hstepA, voffA);
            PG8_WAIT_L(8); PG8_BAR; PG8_WAIT_L(0); PG8_MMA(0, 0, At, B0); PG8_BAR; PG8_SCHED;
            PG8_LDB(B1, 1, 1); PG8_STAGE(PG8_SB(1, 0), b3, voffB);
            PG8_BAR; PG8_WAIT_L(0); PG8_MMA(0, 1, At, B1); PG8_BAR;
            PG8_LDA(At, 1, 1); PG8_STAGE(PG8_SA(1, 0), a3, voffA);
            PG8_BAR; PG8_WAIT_L(0); PG8_MMA(1, 0, At, B0); PG8_BAR; PG8_SCHED;
            PG8_STAGE(PG8_SB(1, 1), b3 + hstepB, voffB);
            PG8_WAIT_V(6); PG8_BAR; PG8_MMA(1, 1, At, B1); PG8_BAR;
            }
        }
        if constexpr (ALIGN_EPI) { if (wr == 0) PG8_BAR; }
        if constexpr (!Epi::AFTER_DRAIN) { int fr_e = fr, fq_e = fq; asm volatile("" : "+v"(fr_e), "+v"(fq_e));
            E(acc, cur, wr, wc, fr_e, fq_e, pblk + upar * PBLK_ALL); upar ^= 1; S.done(cur);
            if constexpr (Epi::NPARAM > 0) { if (has_next) E.stage_params(nxt, pblk + upar * PBLK_ALL, wr, wc, (fq_e << 4) | fr_e); } }
        if (!has_next) break;
#pragma unroll
        for (int a = 0; a < 2; ++a)
#pragma unroll
            for (int b = 0; b < 2; ++b)
#pragma unroll
                for (int m = 0; m < 4; ++m)
#pragma unroll
                    for (int n = 0; n < 2; ++n) acc[a][b][m][n] = (f32x4){0.f, 0.f, 0.f, 0.f};
        cur = nxt; cA = nA; cB = nB; ++ui;
        if constexpr (ALIGN_EPI) { if (wr == 1) PG8_BAR; }
    }
    PG8_WAIT_V(0);
    if constexpr (!ALIGN_EPI) { if (wr == 0) PG8_BAR; }
    PG8_BAR;
    if constexpr (Epi::AFTER_DRAIN) { E.fused(acc, cur, wr, wc, fr, fq, lds, wid, lane); S.done(cur); }
#undef PG8_SA
#undef PG8_SB
#undef PG8_STAGE
#undef PG8_LDA
#undef PG8_LDB
#undef PG8_MMA
#undef PG8_WAIT_V
#undef PG8_WAIT_L
#undef PG8_BAR
#undef PG8_SCHED
}
}
#include <hip/hip_bf16.h>
#include <cmath>
namespace attn_body {
using bf16=__hip_bfloat16;
using bf16x8=__attribute__((ext_vector_type(8)))short;
using s16x4=__attribute__((ext_vector_type(4)))short;
using f32x16=__attribute__((ext_vector_type(16)))float;
using u32x4=__attribute__((ext_vector_type(4)))unsigned;
constexpr int D=64,DM=1536;
constexpr int NW=8,QBLK=32,QB=QBLK*NW,KVBLK=64;
constexpr int ATTN_PITCH=DM, ATTN_UNIT_ROWS=QB;
__device__ __forceinline__ int crow(int r,int hi){return (r&3)+8*(r>>2)+4*hi;}
#define SBAR() __builtin_amdgcn_sched_barrier(0)
__device__ __forceinline__ void cmask(f32x16&p0,f32x16&p1,int jb,int qrel,int hi){
  const float NEG=-INFINITY; int kb=64*jb+4*hi;
  #pragma unroll
  for(int r=0;r<16;++r){int kv=kb+(r&3)+8*(r>>2); if(kv>qrel)p0[r]=NEG; if(kv+32>qrel)p1[r]=NEG;}
}

constexpr int NSLOT=3, SLOTB=8192;
constexpr int LDS_K=0, LDS_V=NSLOT*SLOTB, LDS_WS=2*NSLOT*SLOTB, LDS_OST=LDS_WS+NW*64*4, LDS_BYTES=LDS_OST+NW*4096;
constexpr float C2=0.125f*1.4426950408889634f;
__device__ __forceinline__ void glds16(const void*gsrc,unsigned lds_dst){unsigned keep;
  asm volatile("s_mov_b32 %0, m0\n\ts_mov_b32 m0, %2\n\ts_nop 0\n\tglobal_load_lds_dwordx4 %1, off\n\ts_mov_b32 m0, %0":"=&s"(keep):"v"(gsrc),"s"(lds_dst):"memory");}
__device__ __forceinline__ float max3f(float a,float b,float c){float r;asm("v_max3_f32 %0, %1, %2, %3":"=v"(r):"v"(a),"v"(b),"v"(c));return r;}
__device__ __forceinline__ float max2f(float a,float b){float r;asm("v_max_f32_e32 %0, %1, %2":"=v"(r):"v"(a),"v"(b));return r;}
__device__ __forceinline__ float fadd_s(float a,float b){float r;asm("v_add_f32_e32 %0, %1, %2":"=v"(r):"v"(a),"v"(b));return r;}
__device__ __forceinline__ float fsub_s(float a,float b){float r;asm("v_sub_f32_e32 %0, %1, %2":"=v"(r):"v"(a),"v"(b));return r;}
typedef float f32x2_t __attribute__((ext_vector_type(2))); typedef __bf16 bf16x2_t __attribute__((ext_vector_type(2)));
__device__ __forceinline__ unsigned cvtpk_s(float lo,float hi){f32x2_t v={lo,hi};bf16x2_t b=__builtin_convertvector(v,bf16x2_t);return __builtin_bit_cast(unsigned,b);}
#define WAIT_BAR(N) asm volatile("s_waitcnt vmcnt(" #N ") lgkmcnt(0)\n\ts_barrier":::"memory")

__device__ __forceinline__ void qkt(f32x16&p0,f32x16&p1,const char*Kslot,const bf16x8*qr,const f32x16&negm,int r32,int hi){
  const char*kb=Kslot+hi*1024+r32*16;
  #pragma unroll
  for(int d0=0;d0<4;++d0){
    const bf16x8 b0=*reinterpret_cast<const bf16x8*>(kb+d0*2048);
    const bf16x8 b1=*reinterpret_cast<const bf16x8*>(kb+d0*2048+512);
    if(d0==0){p0=__builtin_amdgcn_mfma_f32_32x32x16_bf16(b0,qr[0],negm,0,0,0);p1=__builtin_amdgcn_mfma_f32_32x32x16_bf16(b1,qr[0],negm,0,0,0);}
    else{p0=__builtin_amdgcn_mfma_f32_32x32x16_bf16(b0,qr[d0],p0,0,0,0);p1=__builtin_amdgcn_mfma_f32_32x32x16_bf16(b1,qr[d0],p1,0,0,0);}}
}
typedef __attribute__((address_space(3))) const char* lds_cptr;
typedef short v4i16_t __attribute__((ext_vector_type(4)));
__device__ __forceinline__ void kload8(bf16x8*kf,lds_cptr kp){
  kf[0]=*(const __attribute__((address_space(3))) bf16x8*)(kp);      kf[1]=*(const __attribute__((address_space(3))) bf16x8*)(kp+512);
  kf[2]=*(const __attribute__((address_space(3))) bf16x8*)(kp+2048); kf[3]=*(const __attribute__((address_space(3))) bf16x8*)(kp+2560);
  kf[4]=*(const __attribute__((address_space(3))) bf16x8*)(kp+4096); kf[5]=*(const __attribute__((address_space(3))) bf16x8*)(kp+4608);
  kf[6]=*(const __attribute__((address_space(3))) bf16x8*)(kp+6144); kf[7]=*(const __attribute__((address_space(3))) bf16x8*)(kp+6656);
}
__device__ __forceinline__ void kload2(bf16x8*kf,lds_cptr kp,int j){ kf[2*j]=*(const __attribute__((address_space(3))) bf16x8*)(kp+j*2048); kf[2*j+1]=*(const __attribute__((address_space(3))) bf16x8*)(kp+j*2048+512); }
__device__ __forceinline__ s16x4 vtr(lds_cptr p){ return __builtin_bit_cast(s16x4,__builtin_amdgcn_ds_read_tr16_b64_v4i16((__attribute__((address_space(3))) v4i16_t*)p)); }
__device__ __forceinline__ float rowmax(const f32x16&p0,const f32x16&p1){
  float a=max3f(p0[0],p0[1],p1[0]),b=max3f(p0[2],p0[3],p1[1]);a=max3f(a,p1[2],p1[3]);
  #pragma unroll
  for(int r=4;r<16;r+=4){a=max3f(a,p0[r],p0[r+1]);b=max3f(b,p0[r+2],p0[r+3]);a=max3f(a,p1[r],p1[r+1]);b=max3f(b,p1[r+2],p1[r+3]);}
  const float m=max2f(a,b);
  auto rr=__builtin_amdgcn_permlane32_swap(__float_as_uint(m),__float_as_uint(m),false,false);
  return max2f(__uint_as_float(rr[0]),__uint_as_float(rr[1]));
}
__device__ __forceinline__ void pv(f32x16*o,int vb,bf16x8 pa0,bf16x8 pa1,bf16x8 pa2,bf16x8 pa3){
  #pragma unroll
  for(int d0=0;d0<2;++d0){s16x4 lo[4],hi[4];
    #pragma unroll
    for(int ks=0;ks<4;++ks){
      asm volatile("ds_read_b64_tr_b16 %0,%1 offset:%c2":"=&v"(lo[ks]):"v"(vb),"i"(d0*4096+ks*1024):"memory");
      asm volatile("ds_read_b64_tr_b16 %0,%1 offset:%c2":"=&v"(hi[ks]):"v"(vb),"i"(d0*4096+ks*1024+512):"memory");}
    asm volatile("s_waitcnt lgkmcnt(0)":::"memory");SBAR();
    #define PK(k) (bf16x8){lo[k][0],lo[k][1],lo[k][2],lo[k][3],hi[k][0],hi[k][1],hi[k][2],hi[k][3]}
    o[d0]=__builtin_amdgcn_mfma_f32_32x32x16_bf16(pa0,PK(0),o[d0],0,0,0);
    o[d0]=__builtin_amdgcn_mfma_f32_32x32x16_bf16(pa1,PK(1),o[d0],0,0,0);
    o[d0]=__builtin_amdgcn_mfma_f32_32x32x16_bf16(pa2,PK(2),o[d0],0,0,0);
    o[d0]=__builtin_amdgcn_mfma_f32_32x32x16_bf16(pa3,PK(3),o[d0],0,0,0);
    #undef PK
  }
}

#ifndef ATTN_STORE16
#define ATTN_STORE16(p,v) (*(u32x4*)(p)=(v))
#endif
template<int THRL> __device__ __forceinline__ void attn_unit(const bf16*Qu,const bf16*__restrict__ Kh,const bf16*__restrict__ Vh,bf16*Ou,const int NT,char*shm){
  const int tid=threadIdx.x,lane=tid&63,r32=lane&31,hi=lane>>5; const int wid=__builtin_amdgcn_readfirstlane(tid>>6);
  const bf16*Qw=Qu+(long)(wid*QBLK)*DM;
  const unsigned lds0=(unsigned)(uintptr_t)shm;
  float*wsf=(float*)(shm+LDS_WS)+wid*64;
  const bf16*ksrc=Kh+(long)lane*DM+wid*8;
  const bf16*vsrc=Vh+(long)(16*(wid&3)+(lane>>2))*DM+(wid>>2)*32+(lane&3)*8;
  const unsigned kdst=lds0+LDS_K+wid*1024, vdst=lds0+LDS_V+wid*1024;
  #define DMA_K(t,slot) glds16(ksrc+(long)(t)*KVBLK*DM,(unsigned)__builtin_amdgcn_readfirstlane(kdst+(slot)))
  #define DMA_V(t,slot) glds16(vsrc+(long)(t)*KVBLK*DM,(unsigned)__builtin_amdgcn_readfirstlane(vdst+(slot)))
  const int vb0=(int)(lds0+LDS_V)+((lane>>4)&1)*32+(lane&3)*8+(4*hi+((lane&15)>>2))*64;
  const char*Kbase=shm+LDS_K; bf16x8 kf[8];
  const lds_cptr shm3=(lds_cptr)shm; const lds_cptr kp0=shm3+LDS_K+hi*1024+r32*16; const lds_cptr vp0=shm3+LDS_V+((lane>>4)&1)*32+(lane&3)*8+(4*hi+((lane&15)>>2))*64;
  DMA_K(0,0);DMA_V(0,0);DMA_K(1,SLOTB);
  bf16x8 qr[4];
  #pragma unroll
  for(int d0=0;d0<4;++d0)qr[d0]=*reinterpret_cast<const bf16x8*>(&Qw[(long)r32*DM+d0*16+hi*8]);
  float mhat=0.f,l_reg=0.f;f32x16 o[2];o[0]=f32x16{};o[1]=f32x16{};f32x16 negm=f32x16{};asm volatile("":"+v"(negm));
  const int qrel=wid*QBLK+r32;
  #define CMASK(P0,P1,t) do{}while(0)
  bool resc=false;
  #define START(P0,P1) do{ const float rm=rowmax(P0,P1); resc=false; \
    { const float dl=rm; mhat=fadd_s(mhat,dl); \
      _Pragma("unroll") for(int r=0;r<16;++r){P0[r]=fsub_s(P0[r],dl);P1[r]=fsub_s(P1[r],dl);} \
      _Pragma("unroll") for(int r=0;r<16;++r)negm[r]=-mhat; asm volatile("":"+v"(negm)); } \
    _Pragma("unroll") for(int r=0;r<16;++r)P0[r]=__builtin_amdgcn_exp2f(P0[r]); }while(0)
  #define RESC() do{ if(resc){ asm volatile("s_waitcnt lgkmcnt(0)":::"memory"); \
      _Pragma("unroll") for(int d_=0;d_<2;++d_) _Pragma("unroll") for(int r=0;r<16;++r)o[d_][r]*=wsf[crow(r,hi)]; } }while(0)
  f32x16 pA0,pA1,pB0,pB1;
  int sl_prev=0,sl_cur=0,sl_next=SLOTB;
  #define ROT() do{sl_prev=sl_cur;sl_cur=sl_next;sl_next=(sl_next==(NSLOT-1)*SLOTB)?0:sl_next+SLOTB;}while(0)
  DMA_K(2,2*SLOTB);
  WAIT_BAR(3);
  qkt(pA0,pA1,Kbase,qr,negm,r32,hi);asm volatile("s_nop 15\n\ts_nop 7":"+v"(pA0),"+v"(pA1));CMASK(pA0,pA1,0);
  START(pA0,pA1);
  _Pragma("unroll") for(int r=0;r<16;++r)pA1[r]=__builtin_amdgcn_exp2f(pA1[r]);
  WAIT_BAR(0);
  DMA_K(3,0);DMA_V(1,SLOTB);
  ROT();
  kload8(kf,kp0+sl_cur);
  WAIT_BAR(2);
  s16x4 vlo[8],vhi[8]; u32x4 pw0,pw1,pw2,pw3;
  #define PKW(P,B) cvtpk_s(P[B],P[B+1])
  #define PAF(k) __builtin_bit_cast(bf16x8,pw##k)
  #define VFR(i) (bf16x8){vlo[i][0],vlo[i][1],vlo[i][2],vlo[i][3],vhi[i][0],vhi[i][1],vhi[i][2],vhi[i][3]}
  #define PIN(x) asm volatile("":"+v"(x))
  #define MX3(a,b,c) __builtin_fmaxf(__builtin_fmaxf((a),(b)),(c))
  #define GAPA(MF,A0,A1,A2,A3,W0,W1,PW) do{ MF; sacc+=A0; sacc+=A1; sacc+=A2; sacc+=A3; PIN(sacc); W0; W1; PIN(PW); SBAR(); }while(0)
  #define EX(v) __builtin_amdgcn_exp2f(v)
  #define GAPB(MF,X,B) do{ MF; X[B]=EX(X[B]); X[B+1]=EX(X[B+1]); X[B+2]=EX(X[B+2]); X[B+3]=EX(X[B+3]); PIN(X); SBAR(); }while(0)
  #define VRD(i) do{ vlo[i]=vtr(vp_+(((i)>>2)*4096+((i)&3)*1024)); vhi[i]=vtr(vp_+(((i)>>2)*4096+((i)&3)*1024+512)); }while(0)
  #define KRD(G,j) do{ if(G){ kload2(kf,kp0+sl_next,j); SBAR(); } }while(0)
  #define STEP(C0,C1,P0,P1,t,GK,GV,GL) do{ SBAR(); \
    const lds_cptr vp_=vp0+sl_prev; \
    VRD(0); SBAR(); float sacc=(P0[0]+P0[1]); \
    GAPA(C0=__builtin_amdgcn_mfma_f32_32x32x16_bf16(kf[0],qr[0],negm,0,0,0), P0[2],P0[3],P0[4],P0[5],     pw0[0]=PKW(P0,0), pw0[1]=PKW(P0,2), pw0); \
    VRD(4); SBAR(); GAPA(C1=__builtin_amdgcn_mfma_f32_32x32x16_bf16(kf[1],qr[0],negm,0,0,0), P0[6],P0[7],P0[8],P0[9],     pw0[2]=PKW(P0,4), pw0[3]=PKW(P0,6), pw0); \
    VRD(1); SBAR(); GAPA(C0=__builtin_amdgcn_mfma_f32_32x32x16_bf16(kf[2],qr[1],C0,0,0,0),   P0[10],P0[11],P0[12],P0[13], pw1[0]=PKW(P0,8), pw1[1]=PKW(P0,10), pw1); \
    VRD(5); SBAR(); GAPA(C1=__builtin_amdgcn_mfma_f32_32x32x16_bf16(kf[3],qr[1],C1,0,0,0),   P0[14],P0[15],P1[0],P1[1],   pw1[2]=PKW(P0,12),pw1[3]=PKW(P0,14), pw1); \
    VRD(2); SBAR(); GAPA(C0=__builtin_amdgcn_mfma_f32_32x32x16_bf16(kf[4],qr[2],C0,0,0,0),   P1[2],P1[3],P1[4],P1[5],     pw2[0]=PKW(P1,0), pw2[1]=PKW(P1,2), pw2); \
    VRD(6); SBAR(); GAPA(C1=__builtin_amdgcn_mfma_f32_32x32x16_bf16(kf[5],qr[2],C1,0,0,0),   P1[6],P1[7],P1[8],P1[9],     pw2[2]=PKW(P1,4), pw2[3]=PKW(P1,6), pw2); \
    VRD(3); SBAR(); GAPA(C0=__builtin_amdgcn_mfma_f32_32x32x16_bf16(kf[6],qr[3],C0,0,0,0),   P1[10],P1[11],P1[12],P1[13], pw3[0]=PKW(P1,8), pw3[1]=PKW(P1,10), pw3); \
    VRD(7); SBAR(); GAPA(C1=__builtin_amdgcn_mfma_f32_32x32x16_bf16(kf[7],qr[3],C1,0,0,0),   P1[14],P1[15],0.f,0.f,       pw3[2]=PKW(P1,12),pw3[3]=PKW(P1,14), pw3); \
    l_reg+=sacc; \
    if(GK){DMA_K((t)+3,sl_cur);} if(GV){DMA_V((t)+1,sl_next);} \
    CMASK(C0,C1,t); \
    { float a=MX3(C0[0],C0[1],C1[0]),b=MX3(C0[2],C0[3],C1[1]); a=MX3(a,C1[2],C1[3]); \
      _Pragma("unroll") for(int r=4;r<16;r+=4){a=MX3(a,C0[r],C0[r+1]);b=MX3(b,C0[r+2],C0[r+3]);a=MX3(a,C1[r],C1[r+1]);b=MX3(b,C1[r+2],C1[r+3]);} \
      float rm=__builtin_fmaxf(a,b); { auto rr=__builtin_amdgcn_permlane32_swap(__float_as_uint(rm),__float_as_uint(rm),false,false); rm=__builtin_fmaxf(__uint_as_float(rr[0]),__uint_as_float(rr[1])); } \
      resc=false; \
      if(__builtin_expect(__any(rm>(float)THRL),0)){ const float dl=__builtin_fmaxf(rm,0.f); mhat+=dl; \
        _Pragma("unroll") for(int r=0;r<16;++r){C0[r]-=dl;C1[r]-=dl;} \
        _Pragma("unroll") for(int r=0;r<16;++r)negm[r]=-mhat; asm volatile("":"+v"(negm)); \
        const float f=__builtin_amdgcn_exp2f(-dl); l_reg*=f; if(hi==0)wsf[r32]=f; resc=true; } } \
    SBAR(); \
    GAPB(o[0]=__builtin_amdgcn_mfma_f32_32x32x16_bf16(PAF(0),VFR(0),o[0],0,0,0), C0,0); \
    GAPB(o[1]=__builtin_amdgcn_mfma_f32_32x32x16_bf16(PAF(0),VFR(4),o[1],0,0,0), C0,4); \
    KRD(GL,0); GAPB(o[0]=__builtin_amdgcn_mfma_f32_32x32x16_bf16(PAF(1),VFR(1),o[0],0,0,0), C0,8); \
    KRD(GL,1); GAPB(o[1]=__builtin_amdgcn_mfma_f32_32x32x16_bf16(PAF(1),VFR(5),o[1],0,0,0), C0,12); \
    KRD(GL,2); GAPB(o[0]=__builtin_amdgcn_mfma_f32_32x32x16_bf16(PAF(2),VFR(2),o[0],0,0,0), C1,0); \
    KRD(GL,3); GAPB(o[1]=__builtin_amdgcn_mfma_f32_32x32x16_bf16(PAF(2),VFR(6),o[1],0,0,0), C1,4); \
    GAPB(o[0]=__builtin_amdgcn_mfma_f32_32x32x16_bf16(PAF(3),VFR(3),o[0],0,0,0), C1,8); \
    GAPB(o[1]=__builtin_amdgcn_mfma_f32_32x32x16_bf16(PAF(3),VFR(7),o[1],0,0,0), C1,12); \
    }while(0)
  int t=1;
  #undef CMASK
  #define CMASK(P0,P1,t) do{}while(0)
  for(;t+5<NT;t+=2){
    STEP(pB0,pB1,pA0,pA1,t,true,true,true);     WAIT_BAR(2); RESC(); ROT();
    STEP(pA0,pA1,pB0,pB1,t+1,true,true,true);   WAIT_BAR(2); RESC(); ROT();
  }
  #undef CMASK
  #define CMASK(P0,P1,t) do{}while(0)
  #define ENDW(tt) do{ if((tt)+3<NT){WAIT_BAR(2);} else if((tt)+2<NT){WAIT_BAR(1);} else {WAIT_BAR(0);} }while(0)
  for(;t+1<NT;t+=2){
    STEP(pB0,pB1,pA0,pA1,t,(t+3<NT),(t+1<NT),(t+1<NT));       ENDW(t);   RESC(); ROT();
    STEP(pA0,pA1,pB0,pB1,t+1,(t+4<NT),(t+2<NT),(t+2<NT));     ENDW(t+1); RESC(); ROT();
  }
  STEP(pB0,pB1,pA0,pA1,NT-1,false,false,false); RESC();
  { float sacc=pB0[0]+pB0[1]; _Pragma("unroll") for(int r=2;r<16;++r)sacc+=pB0[r]; _Pragma("unroll") for(int r=0;r<16;++r)sacc+=pB1[r]; l_reg+=sacc;
    pw0=(u32x4){PKW(pB0,0),PKW(pB0,2),PKW(pB0,4),PKW(pB0,6)};pw1=(u32x4){PKW(pB0,8),PKW(pB0,10),PKW(pB0,12),PKW(pB0,14)};pw2=(u32x4){PKW(pB1,0),PKW(pB1,2),PKW(pB1,4),PKW(pB1,6)};pw3=(u32x4){PKW(pB1,8),PKW(pB1,10),PKW(pB1,12),PKW(pB1,14)};
    SBAR(); pv(o,vb0+sl_cur,PAF(0),PAF(1),PAF(2),PAF(3)); }
  #undef PKW
  #undef PAF
  #undef VFR
  #undef PIN
  #undef MX3
  #undef GAPA
  #undef GAPB
  #undef EX
  #undef VRD
  #undef KRD
  #undef STEP
  #undef ENDW
  {auto rr=__builtin_amdgcn_permlane32_swap(__float_as_uint(l_reg),__float_as_uint(l_reg),false,false);l_reg=__uint_as_float(rr[0])+__uint_as_float(rr[1]);}
  if(hi==0)wsf[32+r32]=l_reg;asm volatile("s_waitcnt lgkmcnt(0)":::"memory");
  float rli[16];
  #pragma unroll
  for(int r=0;r<16;++r)rli[r]=__builtin_amdgcn_rcpf(wsf[32+crow(r,hi)]);
  bf16*Ow=Ou+(long)(wid*QBLK)*DM;
  { bf16*stg=(bf16*)(shm+LDS_OST)+wid*2048;
    #pragma unroll
    for(int r=0;r<16;++r){const int orow=crow(r,hi);
      #pragma unroll
      for(int d0=0;d0<2;++d0)stg[orow*64+d0*32+r32]=__float2bfloat16(o[d0][r]*rli[r]);}
    asm volatile("s_waitcnt lgkmcnt(0)":::"memory");
    #pragma unroll
    for(int i=0;i<4;++i){const int row=i*8+(lane>>3),ch=lane&7; const u32x4 v=*(const u32x4*)(stg+row*64+ch*8); ATTN_STORE16(Ow+(long)row*DM+ch*8,v);} }
  asm volatile("s_waitcnt lgkmcnt(0)\n\ts_barrier":::"memory");
  #undef DMA_K
  #undef DMA_V
  #undef CMASK
  #undef START
  #undef RESC
  #undef ROT
}
constexpr int ATTN_LDS_BYTES=LDS_BYTES;
#undef SBAR
#undef WAIT_BAR
}
#define GAS __attribute__((address_space(1)))
#define LAS __attribute__((address_space(3)))
typedef unsigned short bf16;
typedef unsigned v4u __attribute__((ext_vector_type(4)));
typedef unsigned v2u __attribute__((ext_vector_type(2)));
typedef float f32x4 __attribute__((ext_vector_type(4)));
typedef short bf16x8 __attribute__((ext_vector_type(8)));
#define LDS_WAIT() asm volatile("s_waitcnt lgkmcnt(0)" ::: "memory")
__device__ __forceinline__ unsigned f2bf(float f) { unsigned u = __builtin_bit_cast(unsigned, f); return (u + 0x7fffu + ((u >> 16) & 1u)) >> 16; }
__device__ __forceinline__ unsigned pk2(float lo, float hi) { return f2bf(lo) | (f2bf(hi) << 16); }
__device__ __forceinline__ float bflo(unsigned w) { return __builtin_bit_cast(float, w << 16); }
__device__ __forceinline__ float bfhi(unsigned w) { return __builtin_bit_cast(float, w & 0xffff0000u); }

constexpr int NWAVES = 8, NTHR = 512;
constexpr int M_TOK = 32768, M_P = 16384, DMODEL = 1024, NQKV = 1536, FF = 2816, FF2 = 5632, SGI = 2048, SGI2 = 4096;
constexpr float EPS = 1e-6f;
constexpr size_t MiB = 1u << 20;
constexpr size_t WS_CTL = 0, CTL_BYTES = 1 * MiB;
constexpr size_t WS_WQKV = 1 * MiB, WS_WO = 4 * MiB, WS_WUP0 = 6 * MiB, WS_WDN0 = 17 * MiB, WS_WIN = 23 * MiB, WS_WOUT = 31 * MiB, WS_WUP1 = 35 * MiB, WS_WDN1 = 46 * MiB;
constexpr size_t WS_WS = 51 * MiB + 512 * 1024, WS_XN = 52 * MiB, WS_BIG = 116 * MiB, WS_END = 256 * MiB;
constexpr int LDS_BYTES = 163840;
constexpr size_t WS_BARW = 768 * 1024;
constexpr int LDSCTL_OFF = 131072, MISC_OFF = LDSCTL_OFF + 320;

__device__ __forceinline__ float wave_sum(float v) {
#pragma unroll
    for (int o = 1; o < 64; o <<= 1) v += __shfl_xor(v, o);
    return v;
}
__device__ __forceinline__ void p0_transpose_item(const float* W, const float* gain, int K, int N, bf16* WT, LAS float* scr, int item, int lane, bool ffn_up = false, bool qkv = false) {
    const int nblk = N / 32, kb = item / nblk, nb = item % nblk, k0 = 64 * kb, n0 = 32 * nb;
    int nd0 = n0; if (qkv && n0 < 1280) { const int head = n0 >> 6, bj = (n0 >> 5) & 1; nd0 = 256 * (head >> 2) + 128 * bj + 32 * (head & 3); }
    if (ffn_up) { const int x = n0 < FF ? n0 : n0 - FF; nd0 = 256 * (x / 128) + (x % 128) + (n0 < FF ? 0 : 128); }
    { float wv[32];
#pragma unroll
      for (int i = 0; i < 32; ++i) wv[i] = W[(size_t)(k0 + 2 * i + (lane >> 5)) * N + n0 + (lane & 31)];
      if (gain) {
#pragma unroll
          for (int i = 0; i < 32; ++i) wv[i] *= gain[k0 + 2 * i + (lane >> 5)]; }
#pragma unroll
      for (int i = 0; i < 32; ++i) scr[(2 * i + (lane >> 5)) * 33 + (lane & 31)] = wv[i]; }
    LDS_WAIT(); asm volatile("" ::: "memory");
    const int c = lane & 7;
#pragma unroll
    for (int j = 0; j < 4; ++j) { const int n = (lane >> 3) + 8 * j; const LAS float* s = scr + (8 * c) * 33 + n;
        v4u o; o.x = pk2(s[0 * 33], s[1 * 33]); o.y = pk2(s[2 * 33], s[3 * 33]); o.z = pk2(s[4 * 33], s[5 * 33]); o.w = pk2(s[6 * 33], s[7 * 33]);
        *(v4u*)(WT + (size_t)(nd0 + n) * K + k0 + 8 * c) = o; }
    LDS_WAIT(); asm volatile("" ::: "memory");
}

#define XB_TMO      128
#define XB_XCNT(j)  (256  + 64 * (j))
#define XB_XSUB(j)  (1280 + 64 * (j))
#define XB_XGEN(j)  (2304 + 64 * (j))
#define XB_TOP      3328
#define XB_TOPGEN   3392
#define XCD_BAR_WORDS 3456
#define XB_SPIN_CAP (1u << 18)

__device__ __forceinline__ unsigned xb_ld(unsigned* p)              { return __hip_atomic_load(p, __ATOMIC_RELAXED, __HIP_MEMORY_SCOPE_AGENT); }
__device__ __forceinline__ unsigned xb_add(unsigned* p, unsigned v) { return __hip_atomic_fetch_add(p, v, __ATOMIC_RELAXED, __HIP_MEMORY_SCOPE_AGENT); }
__device__ __forceinline__ unsigned xb_xcc_id() { return (unsigned)__builtin_amdgcn_s_getreg((3 << 11) | 20) & 0xFu; }
#define XB_SPIN(cond, bar) do { unsigned _sp = 0; while (cond) { __builtin_amdgcn_s_sleep(1); \
    if ((++_sp & 255u) == 0u) { if (xb_ld(&(bar)[XB_TMO])) break; if (_sp > XB_SPIN_CAP) { atomicAdd(&(bar)[XB_TMO], 1u); break; } } } } while (0)

struct XcdBarrier {
    unsigned* bar; unsigned x;
    volatile LAS unsigned* st;
};

__device__ __forceinline__ XcdBarrier xcd_barrier_post(unsigned* bar, volatile LAS unsigned* st) {
    XcdBarrier b; b.bar = bar; b.x = xb_xcc_id(); b.st = st;
    if (threadIdx.x == 0) (void)xb_add(&bar[XB_XCNT(b.x)], 1u);
    return b;
}
__device__ __forceinline__ void xcd_barrier_complete(unsigned* bar, unsigned x, unsigned& nloc, unsigned& nx) {
    const unsigned G = gridDim.x * gridDim.y * gridDim.z;
    unsigned sum, cnt, mine, sp = 0u;
    for (;;) {
        sum = 0u; cnt = 0u; mine = 0u;
#pragma unroll
        for (unsigned j = 0; j < 16; ++j) { const unsigned c = xb_ld(&bar[XB_XCNT(j)]); sum += c; cnt += (c > 0u) ? 1u : 0u; mine = (j == x) ? c : mine; }
        if (sum == G) break;
        __builtin_amdgcn_s_sleep(1);
        if ((++sp & 255u) == 0u) { if (xb_ld(&bar[XB_TMO])) break; if (sp > XB_SPIN_CAP) { atomicAdd(&bar[XB_TMO], 1u); break; } }
    }
    nloc = mine > 0u ? mine : 1u; nx = cnt > 0u ? cnt : 1u;
}

__device__ __forceinline__ void xcd_barrier(const XcdBarrier& b) {
    asm volatile("s_waitcnt vmcnt(0)" ::: "memory");
    __syncthreads();
    if (threadIdx.x == 0) {
        unsigned* bar = b.bar; unsigned bx_ = b.x; asm volatile("" : "+s"(bar), "+s"(bx_));
        __builtin_amdgcn_s_waitcnt(0);
        unsigned nloc = b.st[0], nx = b.st[1];
        if (nloc == 0u) { xcd_barrier_complete(bar, bx_, nloc, nx); b.st[0] = nloc; b.st[1] = nx; }
        const unsigned old = xb_add(&bar[XB_XSUB(bx_)], 1u);
        const unsigned gen = old / nloc;
        if (old + 1u == (gen + 1u) * nloc) {
            __builtin_amdgcn_fence(__ATOMIC_RELEASE, "agent");
            asm volatile("s_waitcnt vmcnt(0)" ::: "memory");
            const unsigned og = xb_add(&bar[XB_TOP], 1u);
            const unsigned tg = og / nx;
            if (og + 1u == (tg + 1u) * nx) xb_add(&bar[XB_TOPGEN], 1u);
            else XB_SPIN(xb_ld(&bar[XB_TOPGEN]) == tg, bar);
            __builtin_amdgcn_fence(__ATOMIC_ACQUIRE, "agent");
            xb_add(&bar[XB_XGEN(bx_)], 1u);
            asm volatile("s_waitcnt vmcnt(0)" ::: "memory");
        } else {
            XB_SPIN(xb_ld(&bar[XB_XGEN(bx_)]) == gen, bar);
            __builtin_amdgcn_fence(__ATOMIC_ACQUIRE, "agent");
            asm volatile("s_waitcnt vmcnt(0)" ::: "memory");
        }
    }
    __syncthreads();
}

struct Args { const float* in[17]; float* out; unsigned char* ws; };

__device__ __forceinline__ void p0_prologue(const Args& a, LAS unsigned char* lds, int gw, int NGW, int wave, int lane) {
    unsigned char* ws = a.ws;
    LAS float* scr = (LAS float*)(lds + wave * 16384);
    constexpr int I_QKV = 16 * 48, I_O = 16 * 32, I_UP = 16 * 176, I_DN = 44 * 32, I_IN = 16 * 128, I_OUT = 32 * 32;
    constexpr int NITEMS0 = I_QKV + I_O + I_UP + I_DN, NITEMS1 = I_UP + I_DN + I_IN + I_OUT;
    for (int it = gw; it < NITEMS0; it += NGW) {
        int r = it;
        if (r < I_QKV) { p0_transpose_item(a.in[4], a.in[2], 1024, NQKV, (bf16*)(ws + WS_WQKV), scr, r, lane, false, true); continue; } r -= I_QKV;
        if (r < I_O)   { p0_transpose_item(a.in[7], nullptr, 1024, 1024, (bf16*)(ws + WS_WO), scr, r, lane); continue; } r -= I_O;
        if (r < I_UP)  { p0_transpose_item(a.in[13], a.in[3], 1024, FF2, (bf16*)(ws + WS_WUP0), scr, r, lane, true); continue; } r -= I_UP;
        p0_transpose_item(a.in[16], nullptr, FF, 1024, (bf16*)(ws + WS_WDN0), scr, r, lane);
    }
    float* stat0 = (float*)(ws + WS_CTL);
    bf16* XN = (bf16*)(ws + WS_XN);
    for (int m0 = gw * 4; m0 < M_TOK; m0 += NGW * 4) {
        f32x4 v[4][4];
#pragma unroll
        for (int q = 0; q < 4; ++q) { const int m = m0 + q; const float* xrow = (m < M_P) ? a.in[0] + (size_t)m * 1024 : a.in[1] + (size_t)(m - M_P) * 1024;
            const f32x4* xr = (const f32x4*)xrow + lane;
#pragma unroll
            for (int j = 0; j < 4; ++j) v[q][j] = xr[64 * j]; }
#pragma unroll
        for (int q = 0; q < 4; ++q) { const int m = m0 + q; float s = 0.f;
#pragma unroll
            for (int j = 0; j < 4; ++j) s += (v[q][j].x * v[q][j].x + v[q][j].y * v[q][j].y) + (v[q][j].z * v[q][j].z + v[q][j].w * v[q][j].w);
            s = wave_sum(s);
            v2u* o8 = (v2u*)(XN + (size_t)m * 1024) + lane;
#pragma unroll
            for (int j = 0; j < 4; ++j) { v2u w; w.x = pk2(v[q][j].x, v[q][j].y); w.y = pk2(v[q][j].z, v[q][j].w); o8[64 * j] = w; }
            if (lane == 0) stat0[m] = s; }
    }
}

__device__ __forceinline__ void p0_layer1_weights(const Args& a, LAS unsigned char* lds, int part, int w, int nw, int wave, int lane) {
    asm volatile("" : "+v"(lane));
    unsigned char* ws = a.ws;
    LAS float* scr = (LAS float*)(lds + wave * 16384);
    constexpr int I_UP = 16 * 176, I_DN = 44 * 32, I_IN = 16 * 128, I_OUT = 32 * 32, NITEMS1 = I_UP + I_DN + I_IN + I_OUT, HALFI = NITEMS1 / 2;
#pragma unroll 1
    for (int it = part * HALFI + w; it < (part + 1) * HALFI; it += nw) {
        int r = it;
        if (r < I_UP)  { p0_transpose_item(a.in[13] + (size_t)1024 * FF2, a.in[3] + 1024, 1024, FF2, (bf16*)(ws + WS_WUP1), scr, r, lane, true); continue; } r -= I_UP;
        if (r < I_DN)  { p0_transpose_item(a.in[16] + (size_t)FF * 1024, nullptr, FF, 1024, (bf16*)(ws + WS_WDN1), scr, r, lane); continue; } r -= I_DN;
        if (r < I_IN)  { p0_transpose_item(a.in[8], a.in[2] + 1024, 1024, SGI2, (bf16*)(ws + WS_WIN), scr, r, lane); continue; } r -= I_IN;
        p0_transpose_item(a.in[12], nullptr, SGI, 1024, (bf16*)(ws + WS_WOUT), scr, r, lane);
    }
    if (part == 0) { const float* s = a.in[10]; unsigned* d = (unsigned*)(ws + WS_WS);
      for (int i = w * 64 + lane; i < 8 * 128 * 128 / 2; i += nw * 64) d[i] = pk2(s[2 * i], s[2 * i + 1]); }
}

__device__ __forceinline__ void rope_phase(bf16* QKV, const float* qg, const float* kg, int gw, int NGW, int lane) {
    const int half = lane >> 5, j = lane & 31, i = j & 15, da = (j >> 4) * 32 + i, db = da + 16;
    const float inv_freq = __builtin_amdgcn_exp2f(-(float)i * 0.830482024f);
    const float qga = qg[da], qgb = qg[db], kga = kg[da], kgb = kg[db];
    for (int r = gw; r < M_TOK; r += NGW) {
        const int t = (r < M_P) ? (r & 8191) : (r & 2047);
        const float pos = (float)((j < 16) ? (t >> 6) : (t & 63));
        float rev = pos * inv_freq * 0.15915494309189535f; rev -= floorf(rev);
        const float sn = __builtin_amdgcn_sinf(rev), cs = __builtin_amdgcn_cosf(rev);
        bf16* row = QKV + (size_t)r * NQKV;
#pragma unroll
        for (int it = 0; it < 10; ++it) {
            bf16* p = row + (2 * it + half) * 64;
            float x = __builtin_bit_cast(float, (unsigned)p[da] << 16), y = __builtin_bit_cast(float, (unsigned)p[db] << 16);
            float ss = x * x + y * y;
#pragma unroll
            for (int o = 1; o < 32; o <<= 1) ss += __shfl_xor(ss, o);
            const float rn = __builtin_amdgcn_rsqf(ss * (1.0f / 64.0f) + EPS);
            const bool isq = it < 8;
            x *= rn * (isq ? qga : kga); y *= rn * (isq ? qgb : kgb);
            float ox = x * cs - y * sn, oy = y * cs + x * sn;
            if (isq) { ox *= attn_body::C2; oy *= attn_body::C2; }
            p[da] = (bf16)f2bf(ox); p[db] = (bf16)f2bf(oy);
        }
    }
}

__device__ __forceinline__ void unpack8(const v4u w, float (&f)[8]) { f[0] = bflo(w.x); f[1] = bfhi(w.x); f[2] = bflo(w.y); f[3] = bfhi(w.y); f[4] = bflo(w.z); f[5] = bfhi(w.z); f[6] = bflo(w.w); f[7] = bfhi(w.w); }
__device__ __forceinline__ void ffn_fixup(const bf16* HALO, bf16* ACT, int pm, int grow_h0, const float* cw, const float* cb) {
    int tid = threadIdx.x; asm volatile("" : "+v"(tid));
    constexpr int NCG = FF / 8;
#pragma unroll 1
    for (int it = tid; it < 8 * NCG; it += NTHR) {
        const int cgi = it % NCG, br = it / NCG, blk = pm * 4 + (br >> 1); const bool bot = (br & 1) != 0;
        const int a0 = cgi * 8, ng = 256 * (a0 >> 7) + (a0 & 127);
        const int lrow = blk * 64 + (bot ? 63 : 0), grow = grow_h0 + lrow, L = (grow < M_P) ? 8192 : 2048;
        const bool zp = !bot && ((grow & (L - 1)) == 0), zn = bot && (((grow + 1) & (L - 1)) == 0);
        const bf16* hb = HALO + (size_t)blk * 4 * FF2 + ng;
        const bf16* pp = bot ? hb + 2 * FF2 : hb - FF2; const bf16* pc = bot ? hb + 3 * FF2 : hb; const bf16* pn_ = bot ? hb + 4 * FF2 : hb + FF2;
        float pg[8], pu[8], cg_[8], cu[8], ng_[8], nu[8];
        if (zp) {
#pragma unroll
            for (int e = 0; e < 8; ++e) { pg[e] = 0.f; pu[e] = 0.f; } }
        else { unpack8(*(const v4u*)pp, pg); unpack8(*(const v4u*)(pp + 128), pu); }
        unpack8(*(const v4u*)pc, cg_); unpack8(*(const v4u*)(pc + 128), cu);
        if (zn) {
#pragma unroll
            for (int e = 0; e < 8; ++e) { ng_[e] = 0.f; nu[e] = 0.f; } }
        else { unpack8(*(const v4u*)pn_, ng_); unpack8(*(const v4u*)(pn_ + 128), nu); }
        float o[8];
#pragma unroll
        for (int h = 0; h < 2; ++h) {
            f32x4 wg[3], wu[3];
#pragma unroll
            for (int k = 0; k < 3; ++k) { wg[k] = *(const f32x4*)(cw + k * FF2 + a0 + 4 * h); wu[k] = *(const f32x4*)(cw + k * FF2 + FF + a0 + 4 * h); }
            const f32x4 bg = *(const f32x4*)(cb + a0 + 4 * h), bu = *(const f32x4*)(cb + FF + a0 + 4 * h);
#pragma unroll
            for (int j = 0; j < 4; ++j) { const int e = 4 * h + j;
                const float g = pg[e] * wg[0][j] + cg_[e] * wg[1][j] + ng_[e] * wg[2][j] + bg[j];
                const float u = pu[e] * wu[0][j] + cu[e] * wu[1][j] + nu[e] * wu[2][j] + bu[j];
                o[e] = g * __builtin_amdgcn_rcpf(1.0f + __builtin_amdgcn_exp2f(-1.4426950408889634f * g)) * u; }
        }
        v4u w; w.x = pk2(o[0], o[1]); w.y = pk2(o[2], o[3]); w.z = pk2(o[4], o[5]); w.w = pk2(o[6], o[7]);
        *(v4u*)(ACT + (size_t)lrow * FF + a0) = w;
    }
}

constexpr int SG_PITCH = 272;
__device__ __forceinline__ void sgu_prefetch_v(const bf16* Z, int rloc0, int grow0, int g, const float* vgain, const float* vstat, int tid, v4u (&v)[8], float (&st)[8], f32x4 (&vg)[2]) {
    const int db = tid & 31, qb = tid >> 5, d0 = 8 * db, q0 = 8 * qb;
#pragma unroll
    for (int i = 0; i < 8; ++i) { v[i] = *(const v4u*)(Z + (size_t)(rloc0 + q0 + i) * SGI2 + SGI + 256 * g + d0); st[i] = vstat[grow0 + q0 + i]; }
    vg[0] = *(const f32x4*)(vgain + 256 * g + d0); vg[1] = *(const f32x4*)(vgain + 256 * g + d0 + 4);
}
__device__ __forceinline__ void sgu_prefetch_u(const bf16* Z, int rloc0, int g, int tid, v4u (&uw)[8]) {
#pragma unroll
    for (int i = 0; i < 8; ++i) uw[i] = *(const v4u*)(Z + (size_t)(rloc0 + (tid >> 5) + 16 * i) * SGI2 + 256 * g + 8 * (tid & 31));
}
__device__ __forceinline__ void sgu_phase(LAS unsigned char* lds, bf16* Z, int r0, const bf16* wsb, const float* bs, const float* vgain, const float* vstat, int vcu, int G) {
    int tid_ = threadIdx.x; asm volatile("" : "+v"(tid_));
    const int tid = tid_, lane = tid & 63, wid = __builtin_amdgcn_readfirstlane(tid >> 6), fr = lane & 15, fq = lane >> 4;
    LAS unsigned char* ldsA = lds + 256 * SG_PITCH;
    v4u v[8]; float st[8]; v4u uw[8]; f32x4 vg[2];
    int u = vcu, g_staged = -1;
    constexpr int SP = 528;
    if (u < 1024) sgu_prefetch_v(Z, (u >> 3) * 128, r0 + (u >> 3) * 128, u & 7, vgain, vstat, tid, v, st, vg);
#pragma unroll 1
    for (; u < 1024; u += G) {
        const int g = u & 7, rloc0 = (u >> 3) * 128;
        sgu_prefetch_u(Z, rloc0, g, tid, uw);
        __syncthreads();
        {
            const int db = tid & 31, qb = tid >> 5, d0 = 8 * db;
            float rs[8];
#pragma unroll
            for (int i = 0; i < 8; ++i) rs[i] = __builtin_amdgcn_rsqf(st[i] * (1.0f / 2048.0f) + EPS);
#pragma unroll
            for (int kh = 0; kh < 2; ++kh) {
                float val[8][4];
#pragma unroll
                for (int i = 0; i < 8; ++i) { const unsigned w0 = kh ? v[i].z : v[i].x, w1 = kh ? v[i].w : v[i].y;
                    val[i][0] = bflo(w0) * rs[i] * vg[kh][0]; val[i][1] = bfhi(w0) * rs[i] * vg[kh][1]; val[i][2] = bflo(w1) * rs[i] * vg[kh][2]; val[i][3] = bfhi(w1) * rs[i] * vg[kh][3]; }
#pragma unroll
                for (int k = 0; k < 4; ++k) {
                    v4u o; o.x = pg8::cvt_pk_bf16(val[0][k], val[1][k]); o.y = pg8::cvt_pk_bf16(val[2][k], val[3][k]); o.z = pg8::cvt_pk_bf16(val[4][k], val[5][k]); o.w = pg8::cvt_pk_bf16(val[6][k], val[7][k]);
                    const int d = d0 + 4 * kh + k;
                    *(LAS v4u*)(lds + d * SG_PITCH + ((qb ^ (db & 15)) << 4)) = o;
                }
            }
            if (g != g_staged) { g_staged = g;
#pragma unroll
                for (int i = 0; i < 4; ++i) { const int e = tid + NTHR * i, p = e >> 4, ch = e & 15; *(LAS v4u*)(ldsA + p * SG_PITCH + (ch << 4)) = *(const v4u*)(wsb + (size_t)g * 16384 + (size_t)e * 8); } }
        }
        __syncthreads();
        { const int un = u + G; if (un < 1024) sgu_prefetch_v(Z, (un >> 3) * 128, r0 + (un >> 3) * 128, un & 7, vgain, vstat, tid, v, st, vg); }
        f32x4 acc[8][2];
#pragma unroll
        for (int mt = 0; mt < 8; ++mt)
#pragma unroll
            for (int nt = 0; nt < 2; ++nt) acc[mt][nt] = (f32x4){0.f, 0.f, 0.f, 0.f};
#pragma unroll
        for (int ks = 0; ks < 4; ++ks) {
            bf16x8 bfr[2];
#pragma unroll
            for (int nt = 0; nt < 2; ++nt) { const int d = 32 * wid + 16 * nt + fr; bfr[nt] = *(const LAS bf16x8*)(lds + d * SG_PITCH + ((((4 * ks + fq) ^ ((d >> 3) & 15))) << 4)); }
#pragma unroll
            for (int mt = 0; mt < 8; ++mt) {
                const bf16x8 afr = *(const LAS bf16x8*)(ldsA + (16 * mt + fr) * SG_PITCH + ((4 * ks + fq) << 4));
#pragma unroll
                for (int nt = 0; nt < 2; ++nt) acc[mt][nt] = __builtin_amdgcn_mfma_f32_16x16x32_bf16(bfr[nt], afr, acc[mt][nt], 0, 0, 0);
            }
        }
        __syncthreads();
#pragma unroll
        for (int mt = 0; mt < 8; ++mt) {
            const int p = 16 * mt + fr; const float b1 = bs[g * 128 + p];
#pragma unroll
            for (int nt = 0; nt < 2; ++nt) { const f32x4 sv = acc[mt][nt]; v2u o; o.x = pg8::cvt_pk_bf16(sv[0] + b1, sv[1] + b1); o.y = pg8::cvt_pk_bf16(sv[2] + b1, sv[3] + b1);
                *(LAS v2u*)(lds + p * SP + (32 * wid + 16 * nt + 4 * fq) * 2) = o; }
        }
        __syncthreads();
#pragma unroll
        for (int i = 0; i < 8; ++i) {
            const int row = (tid >> 5) + 16 * i; const v4u sw = *(const LAS v4u*)(lds + row * SP + (tid & 31) * 16); const v4u u4 = uw[i];
            v4u o; o.x = pg8::cvt_pk_bf16(bflo(u4.x) * bflo(sw.x), bfhi(u4.x) * bfhi(sw.x)); o.y = pg8::cvt_pk_bf16(bflo(u4.y) * bflo(sw.y), bfhi(u4.y) * bfhi(sw.y));
            o.z = pg8::cvt_pk_bf16(bflo(u4.z) * bflo(sw.z), bfhi(u4.z) * bfhi(sw.z)); o.w = pg8::cvt_pk_bf16(bflo(u4.w) * bflo(sw.w), bfhi(u4.w) * bfhi(sw.w));
            *(v4u*)(Z + (size_t)(rloc0 + row) * SGI2 + 256 * g + 8 * (tid & 31)) = o;
        }
    }
}

__global__ void __launch_bounds__(NTHR, 2) mk_fwd(Args a) {
    extern __shared__ __attribute__((aligned(16))) unsigned char lds_raw[];
    cg::grid_group grid = cg::this_grid();
    LAS unsigned char* lds = (LAS unsigned char*)lds_raw;
    const int tid = threadIdx.x, lane = tid & 63, wave = __builtin_amdgcn_readfirstlane(tid >> 6);
    const int G = gridDim.x, bx = blockIdx.x, vcu = (G % 8 == 0) ? (bx % 8) * (G / 8) + bx / 8 : bx;
    const int gw = vcu * NWAVES + wave, NGW = G * NWAVES;
    unsigned char* ws = a.ws;
    float* stat0 = (float*)(ws + WS_CTL); float* stat1 = stat0 + M_TOK; float* stat2 = stat1 + M_TOK; float* stat3 = stat2 + M_TOK; float* stat4 = stat3 + M_TOK;
    bf16* XN = (bf16*)(ws + WS_XN); bf16* BIG = (bf16*)(ws + WS_BIG);
    float* out = a.out;
    for (int u = tid; u < (LDS_BYTES - LDSCTL_OFF) / 4; u += NTHR) ((LAS unsigned*)(lds + LDSCTL_OFF))[u] = 0u;
    __syncthreads();
    XcdBarrier bar = xcd_barrier_post((unsigned*)(ws + WS_BARW), (volatile LAS unsigned*)(lds + MISC_OFF) + 8);
#define GSYNC() xcd_barrier(bar)

    p0_prologue(a, lds, gw, NGW, wave, lane);
    if (a.out == nullptr) grid.sync();
    GSYNC();
    { pg8::Gemm g{XN, (const bf16*)(ws + WS_WQKV), M_TOK, NQKV, 1024, 1024, 1024}; pg8::StaticOrder S; S.init(M_TOK, NQKV, G, bx);
      pg8::EpiQKV E{BIG, stat0, a.in[5], a.in[6]};
      pg8::gemm_phase<pg8::EpiQKV, pg8::StaticOrder, true, true>(lds, g, S, E); }
    GSYNC();
    { const attn_body::bf16* QKV = (const attn_body::bf16*)BIG;
      for (int k = vcu * 4; k < 1024; k += G * 4)
          for (int i = 0; i < 4; ++i) { const int u = k + i, bh = u >> 5, qb = u & 31, b = bh >> 4, h = bh & 15; const size_t row0 = (size_t)b * 8192;
              const attn_body::bf16* Qu = QKV + (row0 + qb * 256) * NQKV + h * 64; const attn_body::bf16* Kh = QKV + row0 * NQKV + 1024 + (h >> 2) * 64;
              attn_body::attn_unit<8>(Qu, Kh, Kh + 256, (attn_body::bf16*)Qu, 128, (char*)lds_raw); }
      for (int k = vcu * 4; k < 1024; k += G * 4)
          for (int i = 0; i < 4; ++i) { const int u = k + i, bh = u >> 3, qb = u & 7, b = bh >> 4, h = bh & 15; const size_t row0 = (size_t)M_P + (size_t)b * 2048;
              const attn_body::bf16* Qu = QKV + (row0 + qb * 256) * NQKV + h * 64; const attn_body::bf16* Kh = QKV + row0 * NQKV + 1024 + (h >> 2) * 64;
              attn_body::attn_unit<8>(Qu, Kh, Kh + 256, (attn_body::bf16*)Qu, 32, (char*)lds_raw); }
    }
    GSYNC();
    { pg8::Gemm g{BIG, (const bf16*)(ws + WS_WO), M_TOK, 1024, 1024, NQKV, 1024}; pg8::StaticOrder S; S.init(M_TOK, 1024, G, bx);
      pg8::EpiRes E{nullptr, nullptr, 0x7fffffff, nullptr, XN, stat1, 0, XN};
      pg8::gemm_phase<pg8::EpiRes, pg8::StaticOrder, true, true>(lds, g, S, E); }
    GSYNC();
#pragma unroll 1
    for (int layer = 0; layer < 2; ++layer) {
        if (layer == 1) {
#pragma unroll 1
            for (int hf = 0; hf < 2; ++hf) {
                const int r0 = hf * 16384;
                { pg8::Gemm g{XN + (size_t)r0 * 1024, (const bf16*)(ws + WS_WIN), 16384, SGI2, 1024, 1024, 1024}; pg8::StaticOrder S; S.init(16384, SGI2, G, bx);
                  pg8::EpiBf16S<2> E{BIG, SGI2, stat2, 1.0f / 1024.0f, r0, stat3, SGI};
                  pg8::gemm_phase<pg8::EpiBf16S<2>, pg8::StaticOrder, true, true>(lds, g, S, E); }
                GSYNC();
                sgu_phase(lds, BIG, r0, (const bf16*)(ws + WS_WS), a.in[11], a.in[9], stat3, vcu, G);
                GSYNC();
                { pg8::Gemm g{BIG, (const bf16*)(ws + WS_WOUT), 16384, 1024, SGI, SGI2, SGI}; pg8::StaticOrder S; S.init(16384, 1024, G, bx);
                  pg8::EpiRes E{nullptr, nullptr, 0x7fffffff, nullptr, XN, stat4, r0, XN};
                  pg8::gemm_phase<pg8::EpiRes, pg8::StaticOrder, true, true>(lds, g, S, E); }
                GSYNC();
            }
        }
        const bf16* Wup = (const bf16*)(ws + (layer ? WS_WUP1 : WS_WUP0)); const bf16* Wdn = (const bf16*)(ws + (layer ? WS_WDN1 : WS_WDN0));
        const float* st_in = layer ? stat4 : stat1;
        const float* cw = a.in[14] + (size_t)layer * 3 * FF2; const float* cb = a.in[15] + (size_t)layer * FF2;
        bf16* ACT = BIG; bf16* HALO = BIG + (size_t)16384 * FF;
#pragma unroll 1
        for (int hf = 0; hf < 2; ++hf) {
            const int r0 = hf * 16384;
            { pg8::Gemm g{XN + (size_t)r0 * 1024, Wup, 16384, FF2, 1024, 1024, 1024}; pg8::StaticOrder S; S.init(16384, FF2, G, bx);
              pg8::EpiConv E{ACT, HALO, st_in, r0, cw, cb};
              pg8::gemm_phase<pg8::EpiConv, pg8::StaticOrder, true, true>(lds, g, S, E); }
            if (layer == 0) {
                const bool spare = (G == 256) ? (bx >= 128) : true;
                if (spare) { const int nb = (G == 256) ? 128 : G, bi = (G == 256) ? bx - 128 : bx; p0_layer1_weights(a, lds, hf, bi * NWAVES + wave, nb * NWAVES, wave, lane); }
            }
            GSYNC();
            { pg8::Gemm g{ACT, Wdn, 16384, 1024, FF, FF, FF}; pg8::StaticOrder S; S.init(16384, 1024, G, bx);
              { pg8::Unit uu; for (int i = 0; S.next(i, uu); ++i) ffn_fixup(HALO, ACT, uu.pm, r0, cw, cb); }
              asm volatile("s_waitcnt vmcnt(0)" ::: "memory"); __syncthreads();
              if (layer == 0) { pg8::EpiRes E{nullptr, nullptr, 0x7fffffff, nullptr, XN, stat2, r0, XN};
                  pg8::gemm_phase<pg8::EpiRes, pg8::StaticOrder, true, true>(lds, g, S, E); }
              else { pg8::EpiResF E{nullptr, nullptr, 0x7fffffff, out, nullptr, nullptr, r0, XN};
                  pg8::gemm_phase<pg8::EpiResF, pg8::StaticOrder, true, true>(lds, g, S, E); } }
            if (!(layer == 1 && hf == 1)) GSYNC();
        }
    }
}

extern "C" void kernel_launch(void* const* d_in, const int* in_sizes, int n_in, void* d_out, int out_size, void* d_ws, size_t ws_size, hipStream_t stream) {
    static int grid = 0;
    if (grid == 0) {
        if (n_in != 17 || out_size != M_TOK * 1024 || ws_size < WS_END) { fprintf(stderr, "kernel_launch: unexpected shapes (n_in %d out %d ws %zu)\n", n_in, out_size, ws_size); grid = -1; return; }
        int dev = 0, cus = 0, per_cu = 0;
        if (hipGetDevice(&dev) != hipSuccess || hipDeviceGetAttribute(&cus, hipDeviceAttributeMultiprocessorCount, dev) != hipSuccess) { grid = -1; return; }
        if (hipFuncSetAttribute((const void*)mk_fwd, hipFuncAttributeMaxDynamicSharedMemorySize, LDS_BYTES) != hipSuccess) { fprintf(stderr, "kernel_launch: hipFuncSetAttribute failed\n"); grid = -1; return; }
        if (hipOccupancyMaxActiveBlocksPerMultiprocessor(&per_cu, (const void*)mk_fwd, NTHR, LDS_BYTES) != hipSuccess || per_cu < 1) { fprintf(stderr, "kernel_launch: occupancy query says %d\n", per_cu); per_cu = 1; }
        (void)hipGetLastError();
        grid = cus;
    }
    if (grid < 0) return;
    (void)hipMemsetAsync((char*)d_ws + WS_CTL, 0, CTL_BYTES, stream);
    Args a{};
    for (int i = 0; i < 17; ++i) a.in[i] = (const float*)d_in[i];
    a.out = (float*)d_out; a.ws = (unsigned char*)d_ws;
    void* args[] = {&a};
    hipError_t e = hipLaunchCooperativeKernel((const void*)mk_fwd, dim3(grid), dim3(NTHR), args, LDS_BYTES, stream);
    if (e != hipSuccess) fprintf(stderr, "kernel_launch: cooperative launch failed: %s (grid %d)\n", hipGetErrorString(e), grid);
}
```

```cpp
#include <hip/hip_runtime.h>
#include <hip/hip_cooperative_groups.h>
namespace cg = cooperative_groups;
#include <cstdio>
#include <cstdint>
namespace pg8 {
#define PG8_LAS __attribute__((address_space(3)))
typedef unsigned short bf16_t;
typedef short bf16x8 __attribute__((ext_vector_type(8)));
typedef float f32x4 __attribute__((ext_vector_type(4)));
typedef unsigned u32x4 __attribute__((ext_vector_type(4)));
constexpr int BM = 256, BK = 64, HALF = 128, HTB = HALF * BK * 2  , STAGE_BYTES = 8 * HTB, NXCD = 8, WGM = 8;

__host__ __device__ __forceinline__ int lds_byte(int r, int c) { const int st = (r >> 4) * 2 + (c >> 5), rr = r & 15, cc = c & 31, ob = rr * 64 + cc * 2; return st * 1024 + (ob ^ (((ob >> 9) & 1) << 5)); }
__host__ __device__ __forceinline__ void stage_rc(int b, int& R, int& C) { const int st = b / 1024, sb = b % 1024, swz = sb ^ (((sb >> 9) & 1) << 5); R = (st >> 1) * 16 + swz / 64; C = (st & 1) * 32 + (swz % 64) / 2; }
__host__ __device__ __forceinline__ int perm32(int rho) { const int n = rho >> 4, i = rho & 15; return 8 * (i >> 2) + 4 * n + (i & 3); }

struct Unit { int pm, pn; };
struct Gemm { const bf16_t* A; const bf16_t* Bt; int M, N, K, lda, ldb; };

struct StaticOrder {
    int nM, nN, nwg, G, c;
    __host__ __device__ __forceinline__ void init(int M, int N, int G_, int c_) { nM = M / BM; nN = N / BM; nwg = nM * nN; G = G_; c = c_; }
    __host__ __device__ __forceinline__ bool next(int i, Unit& u) const {
        const long L = (long)i * G + c; if (L >= nwg) return false;
        int wgid = (int)L; { const int q = nwg / NXCD, r = nwg % NXCD, xcd = wgid % NXCD, off = wgid / NXCD; wgid = (xcd < r ? xcd * (q + 1) : r * (q + 1) + (xcd - r) * q) + off; }
        const int nig = WGM * nN, gid = wgid / nig, fm = gid * WGM, gsz = (nM - fm) < WGM ? (nM - fm) : WGM;
        u.pm = fm + ((wgid % nig) % gsz); u.pn = (wgid % nig) / gsz; return true;
    }
    __device__ __forceinline__ void a_ready(const Unit&) const {}
    __device__ __forceinline__ void done(const Unit&) const {}
};

__device__ __forceinline__ unsigned cvt_pk_bf16(float lo, float hi) { unsigned r; asm volatile("v_cvt_pk_bf16_f32 %0, %1, %2" : "=v"(r) : "v"(lo), "v"(hi)); return r; }
typedef float f32x2 __attribute__((ext_vector_type(2)));
__device__ __forceinline__ float gelu_tanh(float x) { const float u = x * x * 0.044715f + 1.0f; const float e = __builtin_amdgcn_exp2f(-2.302208198f * x * u); return x * __builtin_amdgcn_rcpf(1.0f + e); }

template <int ACT> struct EpiBf16S {
    static constexpr bool PERM = true, AFTER_DRAIN = false, ROWPERM = false; static constexpr int NPARAM = 0;
    bf16_t* O; int ldc; const float* rstat; float rdim_inv; int row_off; float* vstat; int vcol0;
    __device__ __forceinline__ void operator()(const f32x4 (&acc)[2][2][4][2], const Unit& u, int wr, int wc, int fr, int fq, PG8_LAS unsigned char* pbuf) const {
        const int row0 = u.pm * BM + wr * 64 + fr, col0 = u.pn * BM + wc * 32 + 8 * fq;
        const bool dov = (vstat != nullptr) && (u.pn * BM >= vcol0);
        float ssv[2][4] = {{0.f, 0.f, 0.f, 0.f}, {0.f, 0.f, 0.f, 0.f}};
#pragma unroll
        for (int ai = 0; ai < 2; ++ai)
#pragma unroll
            for (int m = 0; m < 4; ++m) {
                const int r = row0 + ai * HALF + m * 16;
                float sc = 1.f; if (rstat) sc = __builtin_amdgcn_rsqf(rstat[row_off + r] * rdim_inv + 1e-6f);
                bf16_t* rowp = O + (size_t)r * ldc + col0; float ss = 0.f;
#pragma unroll
                for (int bj = 0; bj < 2; ++bj) { f32x4 v0 = acc[ai][bj][m][0] * sc, v1 = acc[ai][bj][m][1] * sc;
                    if (ACT == 2) {
#pragma unroll
                        for (int j = 0; j < 4; ++j) { v0[j] = gelu_tanh(v0[j]); v1[j] = gelu_tanh(v1[j]); } }
                    ss += (v0[0] * v0[0] + v0[1] * v0[1]) + (v0[2] * v0[2] + v0[3] * v0[3]) + (v1[0] * v1[0] + v1[1] * v1[1]) + (v1[2] * v1[2] + v1[3] * v1[3]);
                    u32x4 w; w.x = cvt_pk_bf16(v0[0], v0[1]); w.y = cvt_pk_bf16(v0[2], v0[3]); w.z = cvt_pk_bf16(v1[0], v1[1]); w.w = cvt_pk_bf16(v1[2], v1[3]);
                    *(u32x4*)(rowp + bj * HALF) = w; }
                if (dov) { ss += __shfl_xor(ss, 16); ss += __shfl_xor(ss, 32); ssv[ai][m] = ss; }
            }
        if (dov) {
#pragma unroll
            for (int ai = 0; ai < 2; ++ai) { const float v = (fq == 0) ? ssv[ai][0] : (fq == 1) ? ssv[ai][1] : (fq == 2) ? ssv[ai][2] : ssv[ai][3];
                atomicAdd(vstat + row_off + u.pm * BM + ai * HALF + wr * 64 + 16 * fq + fr, v); }
        }
    }
};

struct EpiRes {
    static constexpr int NPARAM = 0;
    static constexpr bool PERM = true, AFTER_DRAIN = false, ROWPERM = false;
    const float* base0; const float* base1; int split_row; float* out; bf16_t* xn; float* stat; int row_off; const bf16_t* bbase;
    __device__ __forceinline__ void operator()(const f32x4 (&acc)[2][2][4][2], const Unit& u, int wr, int wc, int fr, int fq, PG8_LAS unsigned char* pbuf) const {
        const int col0 = u.pn * BM + wc * 32 + 8 * fq;
        float ssv[2][4];
#pragma unroll
        for (int ai = 0; ai < 2; ++ai)
#pragma unroll
            for (int m = 0; m < 4; ++m) {
                const int r = row_off + u.pm * BM + ai * HALF + wr * 64 + m * 16 + fr;
                const float* b = (r < split_row) ? base0 + (size_t)r * 1024 : base1 + (size_t)(r - split_row) * 1024;
                float* o = out + (size_t)r * 1024; float ss = 0.f;
#pragma unroll
                for (int bj = 0; bj < 2; ++bj) { const int c = col0 + bj * HALF;
                    f32x4 b0, b1;
                    if (bbase) { const u32x4 w = *(const u32x4*)(bbase + (size_t)r * 1024 + c);
                        b0 = (f32x4){__builtin_bit_cast(float, w.x << 16), __builtin_bit_cast(float, w.x & 0xffff0000u), __builtin_bit_cast(float, w.y << 16), __builtin_bit_cast(float, w.y & 0xffff0000u)};
                        b1 = (f32x4){__builtin_bit_cast(float, w.z << 16), __builtin_bit_cast(float, w.z & 0xffff0000u), __builtin_bit_cast(float, w.w << 16), __builtin_bit_cast(float, w.w & 0xffff0000u)}; }
                    else { b0 = *(const f32x4*)(b + c); b1 = *(const f32x4*)(b + c + 4); }
                    const f32x4 x0 = b0 + acc[ai][bj][m][0], x1 = b1 + acc[ai][bj][m][1];
                    if (out) { *(f32x4*)(o + c) = x0; *(f32x4*)(o + c + 4) = x1; }
                    ss += (x0[0] * x0[0] + x0[1] * x0[1]) + (x0[2] * x0[2] + x0[3] * x0[3]) + (x1[0] * x1[0] + x1[1] * x1[1]) + (x1[2] * x1[2] + x1[3] * x1[3]);
                    if (xn) { u32x4 w; w.x = cvt_pk_bf16(x0[0], x0[1]); w.y = cvt_pk_bf16(x0[2], x0[3]); w.z = cvt_pk_bf16(x1[0], x1[1]); w.w = cvt_pk_bf16(x1[2], x1[3]); *(u32x4*)(xn + (size_t)r * 1024 + c) = w; } }
                ss += __shfl_xor(ss, 16); ss += __shfl_xor(ss, 32); ssv[ai][m] = ss;
                asm volatile("" ::: "memory");
            }
        if (stat) {
#pragma unroll
            for (int ai = 0; ai < 2; ++ai) { const float v = (fq == 0) ? ssv[ai][0] : (fq == 1) ? ssv[ai][1] : (fq == 2) ? ssv[ai][2] : ssv[ai][3];
                atomicAdd(stat + row_off + u.pm * BM + ai * HALF + wr * 64 + 16 * fq + fr, v); }
        }
    }
};

struct EpiResF {
    static constexpr bool PERM = false, AFTER_DRAIN = false, ROWPERM = false; static constexpr int NPARAM = 0;
    const float* base0; const float* base1; int split_row; float* out; bf16_t* xn; float* stat; int row_off; const bf16_t* bbase;
    __device__ __forceinline__ void operator()(const f32x4 (&acc)[2][2][4][2], const Unit& u, int wr, int wc, int fr, int fq, PG8_LAS unsigned char* pbuf) const {
        const int col0 = u.pn * BM + wc * 32 + 4 * fq;
#pragma unroll
        for (int ai = 0; ai < 2; ++ai)
#pragma unroll
            for (int m = 0; m < 4; ++m) {
                const int r = row_off + u.pm * BM + ai * HALF + wr * 64 + m * 16 + fr;
                const float* b = (r < split_row) ? base0 + (size_t)r * 1024 : base1 + (size_t)(r - split_row) * 1024;
                float* o = out + (size_t)r * 1024; float ss = 0.f;
#pragma unroll
                for (int bj = 0; bj < 2; ++bj)
#pragma unroll
                    for (int n = 0; n < 2; ++n) { const int c = col0 + bj * HALF + n * 16;
                        f32x4 bs;
                        if (bbase) { typedef unsigned u32x2w __attribute__((ext_vector_type(2))); const u32x2w w = *(const u32x2w*)(bbase + (size_t)r * 1024 + c);
                            bs = (f32x4){__builtin_bit_cast(float, w.x << 16), __builtin_bit_cast(float, w.x & 0xffff0000u), __builtin_bit_cast(float, w.y << 16), __builtin_bit_cast(float, w.y & 0xffff0000u)}; }
                        else bs = *(const f32x4*)(b + c);
                        const f32x4 x = bs + acc[ai][bj][m][n]; if (out) *(f32x4*)(o + c) = x;
                        ss += (x[0] * x[0] + x[1] * x[1]) + (x[2] * x[2] + x[3] * x[3]);
                        if (xn) { typedef unsigned u32x2v __attribute__((ext_vector_type(2))); u32x2v w; w.x = cvt_pk_bf16(x[0], x[1]); w.y = cvt_pk_bf16(x[2], x[3]); *(u32x2v*)(xn + (size_t)r * 1024 + c) = w; } }
                if (stat) { ss += __shfl_xor(ss, 16); ss += __shfl_xor(ss, 32); if (fq == 0) atomicAdd(stat + r, ss); }
                asm volatile("" ::: "memory");
            }
    }
};

__device__ __forceinline__ float dpp_shr1(float x) { return __builtin_bit_cast(float, __builtin_amdgcn_mov_dpp(__builtin_bit_cast(int, x), 0x111, 0xf, 0xf, true)); }
__device__ __forceinline__ float dpp_shl1(float x) { return __builtin_bit_cast(float, __builtin_amdgcn_mov_dpp(__builtin_bit_cast(int, x), 0x101, 0xf, 0xf, true)); }
__device__ __forceinline__ float dpp_ror1(float x)  { return __builtin_bit_cast(float, __builtin_amdgcn_mov_dpp(__builtin_bit_cast(int, x), 0x121, 0xf, 0xf, true)); }
__device__ __forceinline__ float dpp_ror15(float x) { return __builtin_bit_cast(float, __builtin_amdgcn_mov_dpp(__builtin_bit_cast(int, x), 0x12F, 0xf, 0xf, true)); }
struct EpiConv {
    static constexpr bool PERM = true, AFTER_DRAIN = false, ROWPERM = true;
    static constexpr int NPARAM = 1;
    bf16_t* ACT; bf16_t* HALO; const float* rstat; int row_off; const float* cw; const float* cb;
    __device__ __forceinline__ void stage_params(const Unit& u, PG8_LAS unsigned char* pbuf, int wr, int wc, int lane) const {
        asm volatile("" : "+v"(lane));
        const int cbase = u.pn * 128 + wc * 32;
        { const float* gp;
          if (lane < 32) gp = rstat + row_off + u.pm * BM + (lane >> 4) * HALF + wr * 64 + 4 * (lane & 15);
          else { const int j = lane - 32; gp = cw + (j >> 4) * 5632 + ((j >> 3) & 1) * 2816 + cbase + 4 * (j & 7); }
          __builtin_amdgcn_global_load_lds((const unsigned*)gp, (PG8_LAS unsigned*)pbuf, 16, 0, 0); }
        if (lane < 32) { const int j = lane; const float* gp = ((j >> 4) ? cb : cw + 2 * 5632) + ((j >> 3) & 1) * 2816 + cbase + 4 * (j & 7);
          __builtin_amdgcn_global_load_lds((const unsigned*)gp, (PG8_LAS unsigned*)(pbuf + 1024), 16, 0, 0); }
    }
    __device__ __forceinline__ void operator()(const f32x4 (&acc)[2][2][4][2], const Unit& u, int wr, int wc, int fr, int fq, PG8_LAS unsigned char* pbuf) const {
        const int a0 = u.pn * 128 + wc * 32 + 8 * fq, ng0 = u.pn * 256 + wc * 32 + 8 * fq;
        f32x4 wgA[2][3], wuA[2][3], bgA[2], buA[2], s4A[2];
#pragma unroll
        for (int ai = 0; ai < 2; ++ai) s4A[ai] = *(const PG8_LAS f32x4*)(pbuf + (ai * 64 + 4 * fr) * 4);
#pragma unroll
        for (int n = 0; n < 2; ++n) { const int cg4 = (2 * fq + n) * 16;
#pragma unroll
            for (int k = 0; k < 2; ++k) { wgA[n][k] = *(const PG8_LAS f32x4*)(pbuf + 512 + k * 256 + cg4); wuA[n][k] = *(const PG8_LAS f32x4*)(pbuf + 512 + k * 256 + 128 + cg4); }
            wgA[n][2] = *(const PG8_LAS f32x4*)(pbuf + 1024 + cg4); wuA[n][2] = *(const PG8_LAS f32x4*)(pbuf + 1024 + 128 + cg4);
            bgA[n] = *(const PG8_LAS f32x4*)(pbuf + 1280 + cg4); buA[n] = *(const PG8_LAS f32x4*)(pbuf + 1280 + 128 + cg4); }
#pragma unroll
        for (int ai = 0; ai < 2; ++ai) {
            const int R0 = u.pm * BM + ai * HALF + wr * 64;
            float sc[4];
            { const f32x4 s4 = s4A[ai];
#pragma unroll
              for (int m = 0; m < 4; ++m) sc[m] = __builtin_amdgcn_rsqf(s4[m] * (1.0f / 1024.0f) + 1e-6f); }
            if (fr == 0 || fr == 15) { bf16_t* hb = HALO + (size_t)(R0 >> 6) * 4 * 5632 + ng0;
#pragma unroll
              for (int bj = 0; bj < 2; ++bj)
#pragma unroll
                  for (int m = 0; m < 4; ++m) { const bool mine = (fr == 0) ? (m < 2) : (m >= 2);
                      if (mine) { const f32x4 v0 = acc[ai][bj][m][0] * sc[m], v1 = acc[ai][bj][m][1] * sc[m];
                          u32x4 w; w.x = cvt_pk_bf16(v0[0], v0[1]); w.y = cvt_pk_bf16(v0[2], v0[3]); w.z = cvt_pk_bf16(v1[0], v1[1]); w.w = cvt_pk_bf16(v1[2], v1[3]);
                          *(u32x4*)(hb + (size_t)m * 5632 + bj * HALF) = w; } } }
            unsigned ow[4][4];
#pragma unroll
            for (int n = 0; n < 2; ++n) {
                const f32x4 (&wg)[3] = wgA[n]; const f32x4 (&wu)[3] = wuA[n]; const f32x4 bg = bgA[n], bu = buA[n];
                float keep[4];
#pragma unroll
                for (int j = 0; j < 4; ++j) {
                    float xg[6], xu[6];
#pragma unroll
                    for (int m = 0; m < 4; ++m) { xg[m + 1] = acc[ai][0][m][n][j] * sc[m]; xu[m + 1] = acc[ai][1][m][n][j] * sc[m]; }
                    xg[0] = dpp_shr1(xg[4]); xg[5] = dpp_shl1(xg[1]); xu[0] = dpp_shr1(xu[4]); xu[5] = dpp_shl1(xu[1]);
#pragma unroll
                    for (int m = 0; m < 4; ++m) {
                        const float g = xg[m] * wg[0][j] + xg[m + 1] * wg[1][j] + xg[m + 2] * wg[2][j] + bg[j];
                        const float uu = xu[m] * wu[0][j] + xu[m + 1] * wu[1][j] + xu[m + 2] * wu[2][j] + bu[j];
                        const float av = g * __builtin_amdgcn_rcpf(1.0f + __builtin_amdgcn_exp2f(-1.4426950408889634f * g)) * uu;
                        if (j & 1) ow[m][2 * n + (j >> 1)] = cvt_pk_bf16(keep[m], av); else keep[m] = av;
                    }
                    __builtin_amdgcn_sched_barrier(0);
                }
            }
#pragma unroll
            for (int m = 0; m < 4; ++m) {
                u32x4 w; w.x = ow[m][0]; w.y = ow[m][1]; w.z = ow[m][2]; w.w = ow[m][3];
                const bool edge = (m == 0 && fr == 0) || (m == 3 && fr == 15);
                if (!edge) *(u32x4*)(ACT + (size_t)(R0 + 4 * fr + m) * 2816 + a0) = w;
            }
            asm volatile("" ::: "memory");
        }
    }
};

struct EpiQKV {
    static constexpr bool PERM = false, AFTER_DRAIN = false, ROWPERM = false; static constexpr int NPARAM = 0;
    bf16_t* O; const float* rstat; const float* qg; const float* kg;
    __device__ __forceinline__ void operator()(const f32x4 (&acc)[2][2][4][2], const Unit& u, int wr, int wc, int fr, int fq, PG8_LAS unsigned char* pbuf) const {
        typedef unsigned u32x2v __attribute__((ext_vector_type(2)));
        if (u.pn == 5) {
            const int col0 = 1280 + wc * 32 + 4 * fq;
#pragma unroll
            for (int ai = 0; ai < 2; ++ai)
#pragma unroll
                for (int m = 0; m < 4; ++m) { const int r = u.pm * BM + ai * HALF + wr * 64 + m * 16 + fr; const float sc = __builtin_amdgcn_rsqf(rstat[r] * (1.0f / 1024.0f) + 1e-6f);
#pragma unroll
                    for (int bj = 0; bj < 2; ++bj)
#pragma unroll
                        for (int n = 0; n < 2; ++n) { const f32x4 v = acc[ai][bj][m][n] * sc; u32x2v w; w.x = cvt_pk_bf16(v[0], v[1]); w.y = cvt_pk_bf16(v[2], v[3]);
                            *(u32x2v*)(O + (size_t)r * 1536 + col0 + bj * HALF + n * 16) = w; } }
            return;
        }
        const int head = u.pn * 4 + wc; const bool isq = u.pn < 4; const float* gp = isq ? qg : kg;
        f32x4 gn[2][2];
#pragma unroll
        for (int bj = 0; bj < 2; ++bj)
#pragma unroll
            for (int n = 0; n < 2; ++n) gn[bj][n] = *(const f32x4*)(gp + 32 * bj + 16 * n + 4 * fq);
        float invf[4];
#pragma unroll
        for (int j = 0; j < 4; ++j) invf[j] = __builtin_amdgcn_exp2f(-(float)(4 * fq + j) * 0.830482024f) * 0.15915494309189535f;
        const float osc = isq ? 0.125f * 1.4426950408889634f : 1.0f;
#pragma unroll
        for (int ai = 0; ai < 2; ++ai)
#pragma unroll
            for (int m = 0; m < 4; ++m) {
                const int r = u.pm * BM + ai * HALF + wr * 64 + m * 16 + fr; const float sc = __builtin_amdgcn_rsqf(rstat[r] * (1.0f / 1024.0f) + 1e-6f);
                f32x4 q[2][2]; float ss = 0.f;
#pragma unroll
                for (int bj = 0; bj < 2; ++bj)
#pragma unroll
                    for (int n = 0; n < 2; ++n) { q[bj][n] = acc[ai][bj][m][n] * sc; const f32x4 x = q[bj][n]; ss += (x[0] * x[0] + x[1] * x[1]) + (x[2] * x[2] + x[3] * x[3]); }
                ss += __shfl_xor(ss, 16); ss += __shfl_xor(ss, 32);
                const float rn = __builtin_amdgcn_rsqf(ss * (1.0f / 64.0f) + 1e-6f);
                const int t = (r < 16384) ? (r & 8191) : (r & 2047);
                bf16_t* op = O + (size_t)r * 1536 + head * 64 + 4 * fq;
#pragma unroll
                for (int bj = 0; bj < 2; ++bj) {
                    float pos = (float)(bj ? (t & 63) : (t >> 6)); asm volatile("" : "+v"(pos));
                    float oa[4], ob[4];
#pragma unroll
                    for (int j = 0; j < 4; ++j) {
                        float rev = pos * invf[j]; rev -= __builtin_floorf(rev);
                        const float sn = __builtin_amdgcn_sinf(rev), cs = __builtin_amdgcn_cosf(rev);
                        const float a = q[bj][0][j] * rn * gn[bj][0][j], b = q[bj][1][j] * rn * gn[bj][1][j];
                        oa[j] = (a * cs - b * sn) * osc; ob[j] = (b * cs + a * sn) * osc;
                    }
                    u32x2v wa, wb; wa.x = cvt_pk_bf16(oa[0], oa[1]); wa.y = cvt_pk_bf16(oa[2], oa[3]); wb.x = cvt_pk_bf16(ob[0], ob[1]); wb.y = cvt_pk_bf16(ob[2], ob[3]);
                    *(u32x2v*)(op + 32 * bj) = wa; *(u32x2v*)(op + 32 * bj + 16) = wb;
                    __builtin_amdgcn_sched_barrier(0);
                }
            }
    }
};
template <class Epi, class Sched, bool ALIGN_EPI = false, bool SP2 = false>
__device__ __forceinline__ void gemm_phase(PG8_LAS unsigned char* lds, Gemm g, const Sched& S, const Epi& E) {
    int tid_ = threadIdx.x; asm volatile("" : "+v"(tid_));
    asm volatile("" : "+s"(g.A), "+s"(g.Bt));
    const int tid = tid_, wid = __builtin_amdgcn_readfirstlane(tid >> 6), lane = tid & 63, wr = wid >> 2, wc = wid & 3, fr = lane & 15, fq = lane >> 4;
    const int K = g.K, nt = K / BK;
    unsigned voffA[2], voffB[2];
#pragma unroll
    for (int i = 0; i < 2; ++i) { int R, C; stage_rc(tid * 16 + i * 8192, R, C); const int Rb = Epi::PERM ? ((R & ~31) + perm32(R & 31)) : R;
        const int Ra = Epi::ROWPERM ? ((R & ~63) + 4 * (R & 15) + ((R >> 4) & 3)) : R;
        voffA[i] = (unsigned)(Ra * g.lda + C) * 2u; voffB[i] = (unsigned)(Rb * g.ldb + C) * 2u; }
    const size_t kstep = (size_t)(BK * 2);
    const size_t hstepA = (size_t)HALF * g.lda * 2, hstepB = (size_t)HALF * g.ldb * 2;
    const size_t tstepA = 2 * hstepA, tstepB = 2 * hstepB;
    const unsigned ldsw = (unsigned)wid * 1024u;
    const int aoff = lds_byte(wr * 64 + fr, fq * 8), boff = lds_byte(wc * 32 + fr, fq * 8);
#define PG8_SA(b, h) (((b) * 2 + (h)) * HTB)
#define PG8_SB(b, h) ((4 + (b) * 2 + (h)) * HTB)
#define PG8_STAGE(bufoff, gbase, voff) do { _Pragma("unroll") for (int _i = 0; _i < 2; ++_i) \
        __builtin_amdgcn_global_load_lds((const unsigned*)((const char*)(gbase) + (voff)[_i]), (PG8_LAS unsigned*)(lds + (bufoff) + ldsw + _i * 8192), 16, 0, 0); } while (0)
#define PG8_LDA(dst, b, h) do { _Pragma("unroll") for (int m = 0; m < 4; ++m) _Pragma("unroll") for (int k = 0; k < 2; ++k) dst[m][k] = *(const PG8_LAS bf16x8*)(lds + PG8_SA(b, h) + aoff + m * 2048 + k * 1024); } while (0)
#define PG8_LDB(dst, b, h) do { _Pragma("unroll") for (int n = 0; n < 2; ++n) _Pragma("unroll") for (int k = 0; k < 2; ++k) dst[n][k] = *(const PG8_LAS bf16x8*)(lds + PG8_SB(b, h) + boff + n * 2048 + k * 1024); } while (0)
#define PG8_MMA(ai, bj, At, Bt) do { __builtin_amdgcn_s_setprio(1); _Pragma("unroll") for (int m = 0; m < 4; ++m) _Pragma("unroll") for (int n = 0; n < 2; ++n) _Pragma("unroll") for (int k = 0; k < 2; ++k) \
        acc[ai][bj][m][n] = __builtin_amdgcn_mfma_f32_16x16x32_bf16(Bt[n][k], At[m][k], acc[ai][bj][m][n], 0, 0, 0); __builtin_amdgcn_s_setprio(0); } while (0)
#define PG8_WAIT_V(n) asm volatile("s_waitcnt vmcnt(" #n ")" ::: "memory")
#define PG8_WAIT_L(n) asm volatile("s_waitcnt lgkmcnt(" #n ")" ::: "memory")
#define PG8_BAR __builtin_amdgcn_s_barrier()
#define PG8_SCHED __builtin_amdgcn_sched_barrier(0)
    Unit cur, nxt; int ui = 0;
    constexpr int PBLK_OFF = STAGE_BYTES + 1024, PBLK_WAVE = 1536, PBLK_ALL = 8 * PBLK_WAVE;
    PG8_LAS unsigned char* const pblk = lds + PBLK_OFF + wid * PBLK_WAVE; int upar = 0;
    if (!S.next(0, cur)) return;
    f32x4 acc[2][2][4][2];
#pragma unroll
    for (int a = 0; a < 2; ++a)
#pragma unroll
        for (int b = 0; b < 2; ++b)
#pragma unroll
            for (int m = 0; m < 4; ++m)
#pragma unroll
                for (int n = 0; n < 2; ++n) acc[a][b][m][n] = (f32x4){0.f, 0.f, 0.f, 0.f};
    bf16x8 At[4][2], B0[2][2], B1[2][2];
    const char* cA = (const char*)g.A + (size_t)cur.pm * tstepA; const char* cB = (const char*)g.Bt + (size_t)cur.pn * tstepB;
    S.a_ready(cur);
    if constexpr (Epi::NPARAM > 0) E.stage_params(cur, pblk, wr, wc, lane);
    if constexpr (SP2) {
        PG8_STAGE(PG8_SB(0, 0), cB, voffB); PG8_STAGE(PG8_SB(0, 1), cB + hstepB, voffB); PG8_STAGE(PG8_SA(0, 0), cA, voffA); PG8_STAGE(PG8_SA(0, 1), cA + hstepA, voffA);
        if (wr == 1) PG8_BAR;
        PG8_WAIT_V(2); PG8_BAR;
        PG8_STAGE(PG8_SB(1, 0), cB + kstep, voffB); PG8_STAGE(PG8_SA(1, 0), cA + kstep, voffA); PG8_STAGE(PG8_SB(1, 1), cB + hstepB + kstep, voffB);
        PG8_WAIT_V(6); PG8_BAR;
    } else {
        PG8_STAGE(PG8_SB(0, 0), cB, voffB); PG8_STAGE(PG8_SA(0, 0), cA, voffA); PG8_STAGE(PG8_SB(0, 1), cB + hstepB, voffB); PG8_STAGE(PG8_SA(0, 1), cA + hstepA, voffA);
        if (wr == 1) PG8_BAR;
        PG8_WAIT_V(4); PG8_BAR;
        PG8_STAGE(PG8_SB(1, 0), cB + kstep, voffB); PG8_STAGE(PG8_SA(1, 0), cA + kstep, voffA); PG8_STAGE(PG8_SB(1, 1), cB + hstepB + kstep, voffB);
        PG8_WAIT_V(6); PG8_BAR;
    }
    for (;;) {
        const bool has_next = S.next(ui + 1, nxt);
        const char* nA = has_next ? (const char*)g.A + (size_t)nxt.pm * tstepA : cA; const char* nB = has_next ? (const char*)g.Bt + (size_t)nxt.pn * tstepB : cB;
        for (int t = 0; t < nt; t += 2) {
            const bool last = (t == nt - 2);
            const char* a1 = cA + (size_t)(t + 1) * kstep;
            const char* a2 = last ? nA : cA + (size_t)(t + 2) * kstep; const char* b2 = last ? nB : cB + (size_t)(t + 2) * kstep;
            const char* a3 = a2 + kstep; const char* b3 = b2 + kstep;
            if (last && has_next) S.a_ready(nxt);
            if constexpr (SP2) {
            PG8_LDB(B0, 0, 0); PG8_LDB(B1, 0, 1); PG8_SCHED; PG8_LDA(At, 0, 0); PG8_STAGE(PG8_SA(1, 1), a1 + hstepA, voffA);
            PG8_WAIT_V(8); PG8_WAIT_L(0); PG8_BAR; PG8_MMA(0, 0, At, B0); PG8_MMA(0, 1, At, B1); PG8_BAR; PG8_SCHED;
            PG8_LDA(At, 0, 1); PG8_STAGE(PG8_SB(0, 0), b2, voffB); PG8_STAGE(PG8_SB(0, 1), b2 + hstepB, voffB); PG8_STAGE(PG8_SA(0, 0), a2, voffA);
            PG8_WAIT_V(8); PG8_WAIT_L(0); PG8_BAR; PG8_MMA(1, 0, At, B0); PG8_MMA(1, 1, At, B1); PG8_BAR; PG8_SCHED;
            PG8_LDB(B0, 1, 0); PG8_LDB(B1, 1, 1); PG8_SCHED; PG8_LDA(At, 1, 0); PG8_STAGE(PG8_SA(0, 1), a2 + hstepA, voffA);
            PG8_WAIT_V(8); PG8_WAIT_L(0); PG8_BAR; PG8_MMA(0, 0, At, B0); PG8_MMA(0, 1, At, B1); PG8_BAR; PG8_SCHED;
            PG8_LDA(At, 1, 1); PG8_STAGE(PG8_SB(1, 0), b3, voffB); PG8_STAGE(PG8_SB(1, 1), b3 + hstepB, voffB); PG8_STAGE(PG8_SA(1, 0), a3, voffA);
            PG8_WAIT_V(8); PG8_WAIT_L(0); PG8_BAR; PG8_MMA(1, 0, At, B0); PG8_MMA(1, 1, At, B1); PG8_BAR; PG8_SCHED;
            } else {
            PG8_LDB(B0, 0, 0); PG8_SCHED; PG8_LDA(At, 0, 0); PG8_STAGE(PG8_SA(1, 1), a1 + hstepA, voffA);
            PG8_WAIT_L(8); PG8_BAR; PG8_WAIT_L(0); PG8_MMA(0, 0, At, B0); PG8_BAR; PG8_SCHED;
            PG8_LDB(B1, 0, 1); PG8_STAGE(PG8_SB(0, 0), b2, voffB);
            PG8_BAR; PG8_WAIT_L(0); PG8_MMA(0, 1, At, B1); PG8_BAR;
            PG8_LDA(At, 0, 1); PG8_STAGE(PG8_SA(0, 0), a2, voffA);
            PG8_BAR; PG8_WAIT_L(0); PG8_MMA(1, 0, At, B0); PG8_BAR; PG8_SCHED;
            PG8_STAGE(PG8_SB(0, 1), b2 + hstepB, voffB);
            PG8_WAIT_V(6); PG8_BAR; PG8_MMA(1, 1, At, B1); PG8_BAR;
            PG8_LDB(B0, 1, 0); PG8_SCHED; PG8_LDA(At, 1, 0); PG8_STAGE(PG8_SA(0, 1), a2 + hstepA, voffA);
            PG8_WAIT_L(8); PG8_BAR; PG8_WAIT_L(0); PG8_MMA(0, 0, At, B0); PG8_BAR; PG8_SCHED;
            PG8_LDB(B1, 1, 1); PG8_STAGE(PG8_SB(1, 0), b3, voffB);
            PG8_BAR; PG8_WAIT_L(0); PG8_MMA(0, 1, At, B1); PG8_BAR;
            PG8_LDA(At, 1, 1); PG8_STAGE(PG8_SA(1, 0), a3, voffA);
            PG8_BAR; PG8_WAIT_L(0); PG8_MMA(1, 0, At, B0); PG8_BAR; PG8_SCHED;
            PG8_STAGE(PG8_SB(1, 1), b3 + hstepB, voffB);
            PG8_WAIT_V(6); PG8_BAR; PG8_MMA(1, 1, At, B1); PG8_BAR;
            }
        }
        if constexpr (ALIGN_EPI) { if (wr == 0) PG8_BAR; }
        if constexpr (!Epi::AFTER_DRAIN) { int fr_e = fr, fq_e = fq; asm volatile("" : "+v"(fr_e), "+v"(fq_e));
            E(acc, cur, wr, wc, fr_e, fq_e, pblk + upar * PBLK_ALL); upar ^= 1; S.done(cur);
            if constexpr (Epi::NPARAM > 0) { if (has_next) E.stage_params(nxt, pblk + upar * PBLK_ALL, wr, wc, (fq_e << 4) | fr_e); } }
        if (!has_next) break;
#pragma unroll
        for (int a = 0; a < 2; ++a)
#pragma unroll
            for (int b = 0; b < 2; ++b)
#pragma unroll
                for (int m = 0; m < 4; ++m)
#pragma unroll
                    for (int n = 0; n < 2; ++n) acc[a][b][m][n] = (f32x4){0.f, 0.f, 0.f, 0.f};
        cur = nxt; cA = nA; cB = nB; ++ui;
        if constexpr (ALIGN_EPI) { if (wr == 1) PG8_BAR; }
    }
    PG8_WAIT_V(0);
    if constexpr (!ALIGN_EPI) { if (wr == 0) PG8_BAR; }
    PG8_BAR;
    if constexpr (Epi::AFTER_DRAIN) { E.fused(acc, cur, wr, wc, fr, fq, lds, wid, lane); S.done(cur); }
#undef PG8_SA
#undef PG8_SB
#undef PG8_STAGE
#undef PG8_LDA
#undef PG8_LDB
#undef PG8_MMA
#undef PG8_WAIT_V
#undef PG8_WAIT_L
#undef PG8_BAR
#undef PG8_SCHED
}
}
#include <hip/hip_bf16.h>
#include <cmath>
namespace attn_body {
using bf16=__hip_bfloat16;
using bf16x8=__attribute__((ext_vector_type(8)))short;
using s16x4=__attribute__((ext_vector_type(4)))short;
using f32x16=__attribute__((ext_vector_type(16)))float;
using u32x4=__attribute__((ext_vector_type(4)))unsigned;
constexpr int D=64,DM=1536;
constexpr int NW=8,QBLK=32,QB=QBLK*NW,KVBLK=64;
constexpr int ATTN_PITCH=DM, ATTN_UNIT_ROWS=QB;
__device__ __forceinline__ int crow(int r,int hi){return (r&3)+8*(r>>2)+4*hi;}
#define SBAR() __builtin_amdgcn_sched_barrier(0)
__device__ __forceinline__ void cmask(f32x16&p0,f32x16&p1,int jb,int qrel,int hi){
  const float NEG=-INFINITY; int kb=64*jb+4*hi;
  #pragma unroll
  for(int r=0;r<16;++r){int kv=kb+(r&3)+8*(r>>2); if(kv>qrel)p0[r]=NEG; if(kv+32>qrel)p1[r]=NEG;}
}

constexpr int NSLOT=3, SLOTB=8192;
constexpr int LDS_K=0, LDS_V=NSLOT*SLOTB, LDS_WS=2*NSLOT*SLOTB, LDS_OST=LDS_WS+NW*64*4, LDS_BYTES=LDS_OST+NW*4096;
constexpr float C2=0.125f*1.4426950408889634f;
__device__ __forceinline__ void glds16(const void*gsrc,unsigned lds_dst){unsigned keep;
  asm volatile("s_mov_b32 %0, m0\n\ts_mov_b32 m0, %2\n\ts_nop 0\n\tglobal_load_lds_dwordx4 %1, off\n\ts_mov_b32 m0, %0":"=&s"(keep):"v"(gsrc),"s"(lds_dst):"memory");}
__device__ __forceinline__ float max3f(float a,float b,float c){float r;asm("v_max3_f32 %0, %1, %2, %3":"=v"(r):"v"(a),"v"(b),"v"(c));return r;}
__device__ __forceinline__ float max2f(float a,float b){float r;asm("v_max_f32_e32 %0, %1, %2":"=v"(r):"v"(a),"v"(b));return r;}
__device__ __forceinline__ float fadd_s(float a,float b){float r;asm("v_add_f32_e32 %0, %1, %2":"=v"(r):"v"(a),"v"(b));return r;}
__device__ __forceinline__ float fsub_s(float a,float b){float r;asm("v_sub_f32_e32 %0, %1, %2":"=v"(r):"v"(a),"v"(b));return r;}
typedef float f32x2_t __attribute__((ext_vector_type(2))); typedef __bf16 bf16x2_t __attribute__((ext_vector_type(2)));
__device__ __forceinline__ unsigned cvtpk_s(float lo,float hi){f32x2_t v={lo,hi};bf16x2_t b=__builtin_convertvector(v,bf16x2_t);return __builtin_bit_cast(unsigned,b);}
#define WAIT_BAR(N) asm volatile("s_waitcnt vmcnt(" #N ") lgkmcnt(0)\n\ts_barrier":::"memory")

__device__ __forceinline__ void qkt(f32x16&p0,f32x16&p1,const char*Kslot,const bf16x8*qr,const f32x16&negm,int r32,int hi){
  const char*kb=Kslot+hi*1024+r32*16;
  #pragma unroll
  for(int d0=0;d0<4;++d0){
    const bf16x8 b0=*reinterpret_cast<const bf16x8*>(kb+d0*2048);
    const bf16x8 b1=*reinterpret_cast<const bf16x8*>(kb+d0*2048+512);
    if(d0==0){p0=__builtin_amdgcn_mfma_f32_32x32x16_bf16(b0,qr[0],negm,0,0,0);p1=__builtin_amdgcn_mfma_f32_32x32x16_bf16(b1,qr[0],negm,0,0,0);}
    else{p0=__builtin_amdgcn_mfma_f32_32x32x16_bf16(b0,qr[d0],p0,0,0,0);p1=__builtin_amdgcn_mfma_f32_32x32x16_bf16(b1,qr[d0],p1,0,0,0);}}
}
typedef __attribute__((address_space(3))) const char* lds_cptr;
typedef short v4i16_t __attribute__((ext_vector_type(4)));
__device__ __forceinline__ void kload8(bf16x8*kf,lds_cptr kp){
  kf[0]=*(const __attribute__((address_space(3))) bf16x8*)(kp);      kf[1]=*(const __attribute__((address_space(3))) bf16x8*)(kp+512);
  kf[2]=*(const __attribute__((address_space(3))) bf16x8*)(kp+2048); kf[3]=*(const __attribute__((address_space(3))) bf16x8*)(kp+2560);
  kf[4]=*(const __attribute__((address_space(3))) bf16x8*)(kp+4096); kf[5]=*(const __attribute__((address_space(3))) bf16x8*)(kp+4608);
  kf[6]=*(const __attribute__((address_space(3))) bf16x8*)(kp+6144); kf[7]=*(const __attribute__((address_space(3))) bf16x8*)(kp+6656);
}
__device__ __forceinline__ void kload2(bf16x8*kf,lds_cptr kp,int j){ kf[2*j]=*(const __attribute__((address_space(3))) bf16x8*)(kp+j*2048); kf[2*j+1]=*(const __attribute__((address_space(3))) bf16x8*)(kp+j*2048+512); }
__device__ __forceinline__ s16x4 vtr(lds_cptr p){ return __builtin_bit_cast(s16x4,__builtin_amdgcn_ds_read_tr16_b64_v4i16((__attribute__((address_space(3))) v4i16_t*)p)); }
__device__ __forceinline__ float rowmax(const f32x16&p0,const f32x16&p1){
  float a=max3f(p0[0],p0[1],p1[0]),b=max3f(p0[2],p0[3],p1[1]);a=max3f(a,p1[2],p1[3]);
  #pragma unroll
  for(int r=4;r<16;r+=4){a=max3f(a,p0[r],p0[r+1]);b=max3f(b,p0[r+2],p0[r+3]);a=max3f(a,p1[r],p1[r+1]);b=max3f(b,p1[r+2],p1[r+3]);}
  const float m=max2f(a,b);
  auto rr=__builtin_amdgcn_permlane32_swap(__float_as_uint(m),__float_as_uint(m),false,false);
  return max2f(__uint_as_float(rr[0]),__uint_as_float(rr[1]));
}
__device__ __forceinline__ void pv(f32x16*o,int vb,bf16x8 pa0,bf16x8 pa1,bf16x8 pa2,bf16x8 pa3){
  #pragma unroll
  for(int d0=0;d0<2;++d0){s16x4 lo[4],hi[4];
    #pragma unroll
    for(int ks=0;ks<4;++ks){
      asm volatile("ds_read_b64_tr_b16 %0,%1 offset:%c2":"=&v"(lo[ks]):"v"(vb),"i"(d0*4096+ks*1024):"memory");
      asm volatile("ds_read_b64_tr_b16 %0,%1 offset:%c2":"=&v"(hi[ks]):"v"(vb),"i"(d0*4096+ks*1024+512):"memory");}
    asm volatile("s_waitcnt lgkmcnt(0)":::"memory");SBAR();
    #define PK(k) (bf16x8){lo[k][0],lo[k][1],lo[k][2],lo[k][3],hi[k][0],hi[k][1],hi[k][2],hi[k][3]}
    o[d0]=__builtin_amdgcn_mfma_f32_32x32x16_bf16(pa0,PK(0),o[d0],0,0,0);
    o[d0]=__builtin_amdgcn_mfma_f32_32x32x16_bf16(pa1,PK(1),o[d0],0,0,0);
    o[d0]=__builtin_amdgcn_mfma_f32_32x32x16_bf16(pa2,PK(2),o[d0],0,0,0);
    o[d0]=__builtin_amdgcn_mfma_f32_32x32x16_bf16(pa3,PK(3),o[d0],0,0,0);
    #undef PK
  }
}

#ifndef ATTN_STORE16
#define ATTN_STORE16(p,v) (*(u32x4*)(p)=(v))
#endif
template<int THRL, bool NOMAX> __device__ __forceinline__ void attn_unit(const bf16*Qu,const bf16*__restrict__ Kh,const bf16*__restrict__ Vh,bf16*Ou,const int NT,char*shm){
  const int tid=threadIdx.x,lane=tid&63,r32=lane&31,hi=lane>>5; const int wid=__builtin_amdgcn_readfirstlane(tid>>6);
  const bf16*Qw=Qu+(long)(wid*QBLK)*DM;
  const unsigned lds0=(unsigned)(uintptr_t)shm;
  float*wsf=(float*)(shm+LDS_WS)+wid*64;
  const bf16*ksrc=Kh+(long)lane*DM+wid*8;
  const bf16*vsrc=Vh+(long)(16*(wid&3)+(lane>>2))*DM+(wid>>2)*32+(lane&3)*8;
  const unsigned kdst=lds0+LDS_K+wid*1024, vdst=lds0+LDS_V+wid*1024;
  #define DMA_K(t,slot) glds16(ksrc+(long)(t)*KVBLK*DM,(unsigned)__builtin_amdgcn_readfirstlane(kdst+(slot)))
  #define DMA_V(t,slot) glds16(vsrc+(long)(t)*KVBLK*DM,(unsigned)__builtin_amdgcn_readfirstlane(vdst+(slot)))
  const int vb0=(int)(lds0+LDS_V)+((lane>>4)&1)*32+(lane&3)*8+(4*hi+((lane&15)>>2))*64;
  const char*Kbase=shm+LDS_K; bf16x8 kf[8];
  const lds_cptr shm3=(lds_cptr)shm; const lds_cptr kp0=shm3+LDS_K+hi*1024+r32*16; const lds_cptr vp0=shm3+LDS_V+((lane>>4)&1)*32+(lane&3)*8+(4*hi+((lane&15)>>2))*64;
  DMA_K(0,0);DMA_V(0,0);DMA_K(1,SLOTB);
  bf16x8 qr[4];
  #pragma unroll
  for(int d0=0;d0<4;++d0)qr[d0]=*reinterpret_cast<const bf16x8*>(&Qw[(long)r32*DM+d0*16+hi*8]);
  float mhat=0.f,l_reg=0.f;f32x16 o[2];o[0]=f32x16{};o[1]=f32x16{};f32x16 negm=f32x16{};asm volatile("":"+v"(negm));
  const int qrel=wid*QBLK+r32;
  #define CMASK(P0,P1,t) do{}while(0)
  bool resc=false;
  #define START(P0,P1) do{ const float rm=rowmax(P0,P1); resc=false; \
    { const float dl=rm; mhat=fadd_s(mhat,dl); \
      _Pragma("unroll") for(int r=0;r<16;++r){P0[r]=fsub_s(P0[r],dl);P1[r]=fsub_s(P1[r],dl);} \
      _Pragma("unroll") for(int r=0;r<16;++r)negm[r]=-mhat; asm volatile("":"+v"(negm)); } \
    _Pragma("unroll") for(int r=0;r<16;++r)P0[r]=__builtin_amdgcn_exp2f(P0[r]); }while(0)
  #define RESC() do{ if(resc){ asm volatile("s_waitcnt lgkmcnt(0)":::"memory"); \
      _Pragma("unroll") for(int d_=0;d_<2;++d_) _Pragma("unroll") for(int r=0;r<16;++r)o[d_][r]*=wsf[crow(r,hi)]; } }while(0)
  f32x16 pA0,pA1,pB0,pB1;
  int sl_prev=0,sl_cur=0,sl_next=SLOTB;
  #define ROT() do{sl_prev=sl_cur;sl_cur=sl_next;sl_next=(sl_next==(NSLOT-1)*SLOTB)?0:sl_next+SLOTB;}while(0)
  DMA_K(2,2*SLOTB);
  WAIT_BAR(3);
  qkt(pA0,pA1,Kbase,qr,negm,r32,hi);asm volatile("s_nop 15\n\ts_nop 7":"+v"(pA0),"+v"(pA1));CMASK(pA0,pA1,0);
  START(pA0,pA1);
  _Pragma("unroll") for(int r=0;r<16;++r)pA1[r]=__builtin_amdgcn_exp2f(pA1[r]);
  WAIT_BAR(0);
  DMA_K(3,0);DMA_V(1,SLOTB);
  ROT();
  kload8(kf,kp0+sl_cur);
  WAIT_BAR(2);
  s16x4 vlo[8],vhi[8]; u32x4 pw0,pw1,pw2,pw3;
  #define PKW(P,B) cvtpk_s(P[B],P[B+1])
  #define PAF(k) __builtin_bit_cast(bf16x8,pw##k)
  #define VFR(i) (bf16x8){vlo[i][0],vlo[i][1],vlo[i][2],vlo[i][3],vhi[i][0],vhi[i][1],vhi[i][2],vhi[i][3]}
  #define PIN(x) asm volatile("":"+v"(x))
  #define MX3(a,b,c) __builtin_fmaxf(__builtin_fmaxf((a),(b)),(c))
  #define GAPA(MF,A0,A1,A2,A3,W0,W1,PW) do{ MF; sacc+=A0; sacc+=A1; sacc+=A2; sacc+=A3; PIN(sacc); W0; W1; PIN(PW); SBAR(); }while(0)
  #define EX(v) __builtin_amdgcn_exp2f(v)
  #define GAPB(MF,X,B) do{ MF; X[B]=EX(X[B]); X[B+1]=EX(X[B+1]); X[B+2]=EX(X[B+2]); X[B+3]=EX(X[B+3]); PIN(X); SBAR(); }while(0)
  #define VRD(i) do{ vlo[i]=vtr(vp_+(((i)>>2)*4096+((i)&3)*1024)); vhi[i]=vtr(vp_+(((i)>>2)*4096+((i)&3)*1024+512)); }while(0)
  #define KRD(G,j) do{ if(G){ kload2(kf,kp0+sl_next,j); SBAR(); } }while(0)
  #define STEP(C0,C1,P0,P1,t,GK,GV,GL) do{ SBAR(); \
    const lds_cptr vp_=vp0+sl_prev; \
    VRD(0); SBAR(); float sacc=(P0[0]+P0[1]); \
    GAPA(C0=__builtin_amdgcn_mfma_f32_32x32x16_bf16(kf[0],qr[0],negm,0,0,0), P0[2],P0[3],P0[4],P0[5],     pw0[0]=PKW(P0,0), pw0[1]=PKW(P0,2), pw0); \
    VRD(4); SBAR(); GAPA(C1=__builtin_amdgcn_mfma_f32_32x32x16_bf16(kf[1],qr[0],negm,0,0,0), P0[6],P0[7],P0[8],P0[9],     pw0[2]=PKW(P0,4), pw0[3]=PKW(P0,6), pw0); \
    VRD(1); SBAR(); GAPA(C0=__builtin_amdgcn_mfma_f32_32x32x16_bf16(kf[2],qr[1],C0,0,0,0),   P0[10],P0[11],P0[12],P0[13], pw1[0]=PKW(P0,8), pw1[1]=PKW(P0,10), pw1); \
    VRD(5); SBAR(); GAPA(C1=__builtin_amdgcn_mfma_f32_32x32x16_bf16(kf[3],qr[1],C1,0,0,0),   P0[14],P0[15],P1[0],P1[1],   pw1[2]=PKW(P0,12),pw1[3]=PKW(P0,14), pw1); \
    VRD(2); SBAR(); GAPA(C0=__builtin_amdgcn_mfma_f32_32x32x16_bf16(kf[4],qr[2],C0,0,0,0),   P1[2],P1[3],P1[4],P1[5],     pw2[0]=PKW(P1,0), pw2[1]=PKW(P1,2), pw2); \
    VRD(6); SBAR(); GAPA(C1=__builtin_amdgcn_mfma_f32_32x32x16_bf16(kf[5],qr[2],C1,0,0,0),   P1[6],P1[7],P1[8],P1[9],     pw2[2]=PKW(P1,4), pw2[3]=PKW(P1,6), pw2); \
    VRD(3); SBAR(); GAPA(C0=__builtin_amdgcn_mfma_f32_32x32x16_bf16(kf[6],qr[3],C0,0,0,0),   P1[10],P1[11],P1[12],P1[13], pw3[0]=PKW(P1,8), pw3[1]=PKW(P1,10), pw3); \
    VRD(7); SBAR(); GAPA(C1=__builtin_amdgcn_mfma_f32_32x32x16_bf16(kf[7],qr[3],C1,0,0,0),   P1[14],P1[15],0.f,0.f,       pw3[2]=PKW(P1,12),pw3[3]=PKW(P1,14), pw3); \
    l_reg+=sacc; \
    if(GK){DMA_K((t)+3,sl_cur);} if(GV){DMA_V((t)+1,sl_next);} \
    CMASK(C0,C1,t); \
    if constexpr (!NOMAX) { float a=MX3(C0[0],C0[1],C1[0]),b=MX3(C0[2],C0[3],C1[1]); a=MX3(a,C1[2],C1[3]); \
      _Pragma("unroll") for(int r=4;r<16;r+=4){a=MX3(a,C0[r],C0[r+1]);b=MX3(b,C0[r+2],C0[r+3]);a=MX3(a,C1[r],C1[r+1]);b=MX3(b,C1[r+2],C1[r+3]);} \
      float rm=__builtin_fmaxf(a,b); { auto rr=__builtin_amdgcn_permlane32_swap(__float_as_uint(rm),__float_as_uint(rm),false,false); rm=__builtin_fmaxf(__uint_as_float(rr[0]),__uint_as_float(rr[1])); } \
      resc=false; \
      if(__builtin_expect(__any(rm>(float)THRL),0)){ const float dl=__builtin_fmaxf(rm,0.f); mhat+=dl; \
        _Pragma("unroll") for(int r=0;r<16;++r){C0[r]-=dl;C1[r]-=dl;} \
        _Pragma("unroll") for(int r=0;r<16;++r)negm[r]=-mhat; asm volatile("":"+v"(negm)); \
        const float f=__builtin_amdgcn_exp2f(-dl); l_reg*=f; if(hi==0)wsf[r32]=f; resc=true; } } \
    SBAR(); \
    GAPB(o[0]=__builtin_amdgcn_mfma_f32_32x32x16_bf16(PAF(0),VFR(0),o[0],0,0,0), C0,0); \
    GAPB(o[1]=__builtin_amdgcn_mfma_f32_32x32x16_bf16(PAF(0),VFR(4),o[1],0,0,0), C0,4); \
    KRD(GL,0); GAPB(o[0]=__builtin_amdgcn_mfma_f32_32x32x16_bf16(PAF(1),VFR(1),o[0],0,0,0), C0,8); \
    KRD(GL,1); GAPB(o[1]=__builtin_amdgcn_mfma_f32_32x32x16_bf16(PAF(1),VFR(5),o[1],0,0,0), C0,12); \
    KRD(GL,2); GAPB(o[0]=__builtin_amdgcn_mfma_f32_32x32x16_bf16(PAF(2),VFR(2),o[0],0,0,0), C1,0); \
    KRD(GL,3); GAPB(o[1]=__builtin_amdgcn_mfma_f32_32x32x16_bf16(PAF(2),VFR(6),o[1],0,0,0), C1,4); \
    GAPB(o[0]=__builtin_amdgcn_mfma_f32_32x32x16_bf16(PAF(3),VFR(3),o[0],0,0,0), C1,8); \
    GAPB(o[1]=__builtin_amdgcn_mfma_f32_32x32x16_bf16(PAF(3),VFR(7),o[1],0,0,0), C1,12); \
    }while(0)
  int t=1;
  #undef CMASK
  #define CMASK(P0,P1,t) do{}while(0)
  for(;t+5<NT;t+=2){
    STEP(pB0,pB1,pA0,pA1,t,true,true,true);     WAIT_BAR(2); RESC(); ROT();
    STEP(pA0,pA1,pB0,pB1,t+1,true,true,true);   WAIT_BAR(2); RESC(); ROT();
  }
  #undef CMASK
  #define CMASK(P0,P1,t) do{}while(0)
  #define ENDW(tt) do{ if((tt)+3<NT){WAIT_BAR(2);} else if((tt)+2<NT){WAIT_BAR(1);} else {WAIT_BAR(0);} }while(0)
  for(;t+1<NT;t+=2){
    STEP(pB0,pB1,pA0,pA1,t,(t+3<NT),(t+1<NT),(t+1<NT));       ENDW(t);   RESC(); ROT();
    STEP(pA0,pA1,pB0,pB1,t+1,(t+4<NT),(t+2<NT),(t+2<NT));     ENDW(t+1); RESC(); ROT();
  }
  STEP(pB0,pB1,pA0,pA1,NT-1,false,false,false); RESC();
  { float sacc=pB0[0]+pB0[1]; _Pragma("unroll") for(int r=2;r<16;++r)sacc+=pB0[r]; _Pragma("unroll") for(int r=0;r<16;++r)sacc+=pB1[r]; l_reg+=sacc;
    pw0=(u32x4){PKW(pB0,0),PKW(pB0,2),PKW(pB0,4),PKW(pB0,6)};pw1=(u32x4){PKW(pB0,8),PKW(pB0,10),PKW(pB0,12),PKW(pB0,14)};pw2=(u32x4){PKW(pB1,0),PKW(pB1,2),PKW(pB1,4),PKW(pB1,6)};pw3=(u32x4){PKW(pB1,8),PKW(pB1,10),PKW(pB1,12),PKW(pB1,14)};
    SBAR(); pv(o,vb0+sl_cur,PAF(0),PAF(1),PAF(2),PAF(3)); }
  #undef PKW
  #undef PAF
  #undef VFR
  #undef PIN
  #undef MX3
  #undef GAPA
  #undef GAPB
  #undef EX
  #undef VRD
  #undef KRD
  #undef STEP
  #undef ENDW
  {auto rr=__builtin_amdgcn_permlane32_swap(__float_as_uint(l_reg),__float_as_uint(l_reg),false,false);l_reg=__uint_as_float(rr[0])+__uint_as_float(rr[1]);}
  if(hi==0)wsf[32+r32]=l_reg;asm volatile("s_waitcnt lgkmcnt(0)":::"memory");
  float rli[16];
  #pragma unroll
  for(int r=0;r<16;++r)rli[r]=__builtin_amdgcn_rcpf(wsf[32+crow(r,hi)]);
  bf16*Ow=Ou+(long)(wid*QBLK)*DM;
  { bf16*stg=(bf16*)(shm+LDS_OST)+wid*2048;
    #pragma unroll
    for(int r=0;r<16;++r){const int orow=crow(r,hi);
      #pragma unroll
      for(int d0=0;d0<2;++d0)stg[orow*64+d0*32+r32]=__float2bfloat16(o[d0][r]*rli[r]);}
    asm volatile("s_waitcnt lgkmcnt(0)":::"memory");
    #pragma unroll
    for(int i=0;i<4;++i){const int row=i*8+(lane>>3),ch=lane&7; const u32x4 v=*(const u32x4*)(stg+row*64+ch*8); ATTN_STORE16(Ow+(long)row*DM+ch*8,v);} }
  asm volatile("s_waitcnt lgkmcnt(0)\n\ts_barrier":::"memory");
  #undef DMA_K
  #undef DMA_V
  #undef CMASK
  #undef START
  #undef RESC
  #undef ROT
}
constexpr int ATTN_LDS_BYTES=LDS_BYTES;
#undef SBAR
#undef WAIT_BAR
}
#define GAS __attribute__((address_space(1)))
#define LAS __attribute__((address_space(3)))
typedef unsigned short bf16;
typedef unsigned v4u __attribute__((ext_vector_type(4)));
typedef unsigned v2u __attribute__((ext_vector_type(2)));
typedef float f32x4 __attribute__((ext_vector_type(4)));
typedef short bf16x8 __attribute__((ext_vector_type(8)));
#define LDS_WAIT() asm volatile("s_waitcnt lgkmcnt(0)" ::: "memory")
__device__ __forceinline__ unsigned f2bf(float f) { unsigned u = __builtin_bit_cast(unsigned, f); return (u + 0x7fffu + ((u >> 16) & 1u)) >> 16; }
__device__ __forceinline__ unsigned pk2(float lo, float hi) { return f2bf(lo) | (f2bf(hi) << 16); }
__device__ __forceinline__ float bflo(unsigned w) { return __builtin_bit_cast(float, w << 16); }
__device__ __forceinline__ float bfhi(unsigned w) { return __builtin_bit_cast(float, w & 0xffff0000u); }

constexpr int NWAVES = 8, NTHR = 512;
constexpr int M_TOK = 32768, M_P = 16384, DMODEL = 1024, NQKV = 1536, FF = 2816, FF2 = 5632, SGI = 2048, SGI2 = 4096;
constexpr float EPS = 1e-6f;
constexpr size_t MiB = 1u << 20;
constexpr size_t WS_CTL = 0, CTL_BYTES = 1 * MiB;
constexpr size_t WS_WQKV = 1 * MiB, WS_WO = 4 * MiB, WS_WUP0 = 6 * MiB, WS_WDN0 = 17 * MiB, WS_WIN = 23 * MiB, WS_WOUT = 31 * MiB, WS_WUP1 = 35 * MiB, WS_WDN1 = 46 * MiB;
constexpr size_t WS_WS = 51 * MiB + 512 * 1024, WS_XN = 52 * MiB, WS_BIG = 116 * MiB, WS_END = 256 * MiB;
constexpr int LDS_BYTES = 163840;
constexpr size_t WS_BARW = 768 * 1024;
constexpr int LDSCTL_OFF = 131072, MISC_OFF = LDSCTL_OFF + 320;

__device__ __forceinline__ float wave_sum(float v) {
#pragma unroll
    for (int o = 1; o < 64; o <<= 1) v += __shfl_xor(v, o);
    return v;
}
__device__ __forceinline__ void p0_transpose_item(const float* W, const float* gain, int K, int N, bf16* WT, LAS float* scr, int item, int lane, bool ffn_up = false, bool qkv = false) {
    const int nblk = N / 32, kb = item / nblk, nb = item % nblk, k0 = 64 * kb, n0 = 32 * nb;
    int nd0 = n0; if (qkv && n0 < 1280) { const int head = n0 >> 6, bj = (n0 >> 5) & 1; nd0 = 256 * (head >> 2) + 128 * bj + 32 * (head & 3); }
    if (ffn_up) { const int x = n0 < FF ? n0 : n0 - FF; nd0 = 256 * (x / 128) + (x % 128) + (n0 < FF ? 0 : 128); }
    { float wv[32];
#pragma unroll
      for (int i = 0; i < 32; ++i) wv[i] = W[(size_t)(k0 + 2 * i + (lane >> 5)) * N + n0 + (lane & 31)];
      if (gain) {
#pragma unroll
          for (int i = 0; i < 32; ++i) wv[i] *= gain[k0 + 2 * i + (lane >> 5)]; }
#pragma unroll
      for (int i = 0; i < 32; ++i) scr[(2 * i + (lane >> 5)) * 33 + (lane & 31)] = wv[i]; }
    LDS_WAIT(); asm volatile("" ::: "memory");
    const int c = lane & 7;
#pragma unroll
    for (int j = 0; j < 4; ++j) { const int n = (lane >> 3) + 8 * j; const LAS float* s = scr + (8 * c) * 33 + n;
        v4u o; o.x = pk2(s[0 * 33], s[1 * 33]); o.y = pk2(s[2 * 33], s[3 * 33]); o.z = pk2(s[4 * 33], s[5 * 33]); o.w = pk2(s[6 * 33], s[7 * 33]);
        *(v4u*)(WT + (size_t)(nd0 + n) * K + k0 + 8 * c) = o; }
    LDS_WAIT(); asm volatile("" ::: "memory");
}

#define XB_TMO      128
#define XB_XCNT(j)  (256  + 64 * (j))
#define XB_XSUB(j)  (1280 + 64 * (j))
#define XB_XGEN(j)  (2304 + 64 * (j))
#define XB_TOP      3328
#define XB_TOPGEN   3392
#define XCD_BAR_WORDS 3456
#define XB_SPIN_CAP (1u << 18)

__device__ __forceinline__ unsigned xb_ld(unsigned* p)              { return __hip_atomic_load(p, __ATOMIC_RELAXED, __HIP_MEMORY_SCOPE_AGENT); }
__device__ __forceinline__ unsigned xb_add(unsigned* p, unsigned v) { return __hip_atomic_fetch_add(p, v, __ATOMIC_RELAXED, __HIP_MEMORY_SCOPE_AGENT); }
__device__ __forceinline__ unsigned xb_xcc_id() { return (unsigned)__builtin_amdgcn_s_getreg((3 << 11) | 20) & 0xFu; }
#define XB_SPIN(cond, bar) do { unsigned _sp = 0; while (cond) { __builtin_amdgcn_s_sleep(1); \
    if ((++_sp & 255u) == 0u) { if (xb_ld(&(bar)[XB_TMO])) break; if (_sp > XB_SPIN_CAP) { atomicAdd(&(bar)[XB_TMO], 1u); break; } } } } while (0)

struct XcdBarrier {
    unsigned* bar; unsigned x;
    volatile LAS unsigned* st;
};

__device__ __forceinline__ XcdBarrier xcd_barrier_post(unsigned* bar, volatile LAS unsigned* st) {
    XcdBarrier b; b.bar = bar; b.x = xb_xcc_id(); b.st = st;
    if (threadIdx.x == 0) (void)xb_add(&bar[XB_XCNT(b.x)], 1u);
    return b;
}
__device__ __forceinline__ void xcd_barrier_complete(unsigned* bar, unsigned x, unsigned& nloc, unsigned& nx) {
    const unsigned G = gridDim.x * gridDim.y * gridDim.z;
    unsigned sum, cnt, mine, sp = 0u;
    for (;;) {
        sum = 0u; cnt = 0u; mine = 0u;
#pragma unroll
        for (unsigned j = 0; j < 16; ++j) { const unsigned c = xb_ld(&bar[XB_XCNT(j)]); sum += c; cnt += (c > 0u) ? 1u : 0u; mine = (j == x) ? c : mine; }
        if (sum == G) break;
        __builtin_amdgcn_s_sleep(1);
        if ((++sp & 255u) == 0u) { if (xb_ld(&bar[XB_TMO])) break; if (sp > XB_SPIN_CAP) { atomicAdd(&bar[XB_TMO], 1u); break; } }
    }
    nloc = mine > 0u ? mine : 1u; nx = cnt > 0u ? cnt : 1u;
}

__device__ __forceinline__ void xcd_barrier(const XcdBarrier& b) {
    asm volatile("s_waitcnt vmcnt(0)" ::: "memory");
    __syncthreads();
    if (threadIdx.x == 0) {
        unsigned* bar = b.bar; unsigned bx_ = b.x; asm volatile("" : "+s"(bar), "+s"(bx_));
        __builtin_amdgcn_s_waitcnt(0);
        unsigned nloc = b.st[0], nx = b.st[1];
        if (nloc == 0u) { xcd_barrier_complete(bar, bx_, nloc, nx); b.st[0] = nloc; b.st[1] = nx; }
        const unsigned old = xb_add(&bar[XB_XSUB(bx_)], 1u);
        const unsigned gen = old / nloc;
        if (old + 1u == (gen + 1u) * nloc) {
            __builtin_amdgcn_fence(__ATOMIC_RELEASE, "agent");
            asm volatile("s_waitcnt vmcnt(0)" ::: "memory");
            const unsigned og = xb_add(&bar[XB_TOP], 1u);
            const unsigned tg = og / nx;
            if (og + 1u == (tg + 1u) * nx) xb_add(&bar[XB_TOPGEN], 1u);
            else XB_SPIN(xb_ld(&bar[XB_TOPGEN]) == tg, bar);
            __builtin_amdgcn_fence(__ATOMIC_ACQUIRE, "agent");
            xb_add(&bar[XB_XGEN(bx_)], 1u);
            asm volatile("s_waitcnt vmcnt(0)" ::: "memory");
        } else {
            XB_SPIN(xb_ld(&bar[XB_XGEN(bx_)]) == gen, bar);
            __builtin_amdgcn_fence(__ATOMIC_ACQUIRE, "agent");
            asm volatile("s_waitcnt vmcnt(0)" ::: "memory");
        }
    }
    __syncthreads();
}

struct Args { const float* in[17]; float* out; unsigned char* ws; };

__device__ __forceinline__ void p0_prologue(const Args& a, LAS unsigned char* lds, int gw, int NGW, int wave, int lane) {
    unsigned char* ws = a.ws;
    LAS float* scr = (LAS float*)(lds + wave * 16384);
    constexpr int I_QKV = 16 * 48, I_O = 16 * 32, I_UP = 16 * 176, I_DN = 44 * 32, I_IN = 16 * 128, I_OUT = 32 * 32;
    constexpr int NITEMS0 = I_QKV + I_O + I_UP + I_DN, NITEMS1 = I_UP + I_DN + I_IN + I_OUT;
    for (int it = gw; it < NITEMS0; it += NGW) {
        int r = it;
        if (r < I_QKV) { p0_transpose_item(a.in[4], a.in[2], 1024, NQKV, (bf16*)(ws + WS_WQKV), scr, r, lane, false, true); continue; } r -= I_QKV;
        if (r < I_O)   { p0_transpose_item(a.in[7], nullptr, 1024, 1024, (bf16*)(ws + WS_WO), scr, r, lane); continue; } r -= I_O;
        if (r < I_UP)  { p0_transpose_item(a.in[13], a.in[3], 1024, FF2, (bf16*)(ws + WS_WUP0), scr, r, lane, true); continue; } r -= I_UP;
        p0_transpose_item(a.in[16], nullptr, FF, 1024, (bf16*)(ws + WS_WDN0), scr, r, lane);
    }
    float* stat0 = (float*)(ws + WS_CTL);
    bf16* XN = (bf16*)(ws + WS_XN);
    for (int m0 = gw * 4; m0 < M_TOK; m0 += NGW * 4) {
        f32x4 v[4][4];
#pragma unroll
        for (int q = 0; q < 4; ++q) { const int m = m0 + q; const float* xrow = (m < M_P) ? a.in[0] + (size_t)m * 1024 : a.in[1] + (size_t)(m - M_P) * 1024;
            const f32x4* xr = (const f32x4*)xrow + lane;
#pragma unroll
            for (int j = 0; j < 4; ++j) v[q][j] = xr[64 * j]; }
#pragma unroll
        for (int q = 0; q < 4; ++q) { const int m = m0 + q; float s = 0.f;
#pragma unroll
            for (int j = 0; j < 4; ++j) s += (v[q][j].x * v[q][j].x + v[q][j].y * v[q][j].y) + (v[q][j].z * v[q][j].z + v[q][j].w * v[q][j].w);
            s = wave_sum(s);
            v2u* o8 = (v2u*)(XN + (size_t)m * 1024) + lane;
#pragma unroll
            for (int j = 0; j < 4; ++j) { v2u w; w.x = pk2(v[q][j].x, v[q][j].y); w.y = pk2(v[q][j].z, v[q][j].w); o8[64 * j] = w; }
            if (lane == 0) stat0[m] = s; }
    }
}

__device__ __forceinline__ void p0_layer1_weights(const Args& a, LAS unsigned char* lds, int part, int w, int nw, int wave, int lane) {
    asm volatile("" : "+v"(lane));
    asm volatile("" : "+s"(nw), "+s"(w));
    unsigned char* ws = a.ws;
    LAS float* scr = (LAS float*)(lds + wave * 16384);
    constexpr int I_UP = 16 * 176, I_DN = 44 * 32, I_IN = 16 * 128, I_OUT = 32 * 32, NITEMS1 = I_UP + I_DN + I_IN + I_OUT, HALFI = NITEMS1 / 2;
#pragma unroll 1
    for (int it = part * HALFI + w; it < (part + 1) * HALFI; it += nw) {
        int r = it;
        if (r < I_UP)  { p0_transpose_item(a.in[13] + (size_t)1024 * FF2, a.in[3] + 1024, 1024, FF2, (bf16*)(ws + WS_WUP1), scr, r, lane, true); continue; } r -= I_UP;
        if (r < I_DN)  { p0_transpose_item(a.in[16] + (size_t)FF * 1024, nullptr, FF, 1024, (bf16*)(ws + WS_WDN1), scr, r, lane); continue; } r -= I_DN;
        if (r < I_IN)  { p0_transpose_item(a.in[8], a.in[2] + 1024, 1024, SGI2, (bf16*)(ws + WS_WIN), scr, r, lane); continue; } r -= I_IN;
        p0_transpose_item(a.in[12], nullptr, SGI, 1024, (bf16*)(ws + WS_WOUT), scr, r, lane);
    }
    if (part == 0) { const float* s = a.in[10]; unsigned* d = (unsigned*)(ws + WS_WS);
      for (int i = w * 64 + lane; i < 8 * 128 * 128 / 2; i += nw * 64) d[i] = pk2(s[2 * i], s[2 * i + 1]); }
}

__device__ __forceinline__ void rope_phase(bf16* QKV, const float* qg, const float* kg, int gw, int NGW, int lane) {
    const int half = lane >> 5, j = lane & 31, i = j & 15, da = (j >> 4) * 32 + i, db = da + 16;
    const float inv_freq = __builtin_amdgcn_exp2f(-(float)i * 0.830482024f);
    const float qga = qg[da], qgb = qg[db], kga = kg[da], kgb = kg[db];
    for (int r = gw; r < M_TOK; r += NGW) {
        const int t = (r < M_P) ? (r & 8191) : (r & 2047);
        const float pos = (float)((j < 16) ? (t >> 6) : (t & 63));
        float rev = pos * inv_freq * 0.15915494309189535f; rev -= floorf(rev);
        const float sn = __builtin_amdgcn_sinf(rev), cs = __builtin_amdgcn_cosf(rev);
        bf16* row = QKV + (size_t)r * NQKV;
#pragma unroll
        for (int it = 0; it < 10; ++it) {
            bf16* p = row + (2 * it + half) * 64;
            float x = __builtin_bit_cast(float, (unsigned)p[da] << 16), y = __builtin_bit_cast(float, (unsigned)p[db] << 16);
            float ss = x * x + y * y;
#pragma unroll
            for (int o = 1; o < 32; o <<= 1) ss += __shfl_xor(ss, o);
            const float rn = __builtin_amdgcn_rsqf(ss * (1.0f / 64.0f) + EPS);
            const bool isq = it < 8;
            x *= rn * (isq ? qga : kga); y *= rn * (isq ? qgb : kgb);
            float ox = x * cs - y * sn, oy = y * cs + x * sn;
            if (isq) { ox *= attn_body::C2; oy *= attn_body::C2; }
            p[da] = (bf16)f2bf(ox); p[db] = (bf16)f2bf(oy);
        }
    }
}

__device__ __forceinline__ void unpack8(const v4u w, float (&f)[8]) { f[0] = bflo(w.x); f[1] = bfhi(w.x); f[2] = bflo(w.y); f[3] = bfhi(w.y); f[4] = bflo(w.z); f[5] = bfhi(w.z); f[6] = bflo(w.w); f[7] = bfhi(w.w); }
__device__ __forceinline__ void ffn_fixup(const bf16* HALO, bf16* ACT, int pm, int grow_h0, const float* cw, const float* cb) {
    int tid = threadIdx.x; asm volatile("" : "+v"(tid));
    constexpr int NCG = FF / 8;
#pragma unroll 1
    for (int it = tid; it < 8 * NCG; it += NTHR) {
        const int cgi = it % NCG, br = it / NCG, blk = pm * 4 + (br >> 1); const bool bot = (br & 1) != 0;
        const int a0 = cgi * 8, ng = 256 * (a0 >> 7) + (a0 & 127);
        const int lrow = blk * 64 + (bot ? 63 : 0), grow = grow_h0 + lrow, L = (grow < M_P) ? 8192 : 2048;
        const bool zp = !bot && ((grow & (L - 1)) == 0), zn = bot && (((grow + 1) & (L - 1)) == 0);
        const bf16* hb = HALO + (size_t)blk * 4 * FF2 + ng;
        const bf16* pp = bot ? hb + 2 * FF2 : hb - FF2; const bf16* pc = bot ? hb + 3 * FF2 : hb; const bf16* pn_ = bot ? hb + 4 * FF2 : hb + FF2;
        float pg[8], pu[8], cg_[8], cu[8], ng_[8], nu[8];
        if (zp) {
#pragma unroll
            for (int e = 0; e < 8; ++e) { pg[e] = 0.f; pu[e] = 0.f; } }
        else { unpack8(*(const v4u*)pp, pg); unpack8(*(const v4u*)(pp + 128), pu); }
        unpack8(*(const v4u*)pc, cg_); unpack8(*(const v4u*)(pc + 128), cu);
        if (zn) {
#pragma unroll
            for (int e = 0; e < 8; ++e) { ng_[e] = 0.f; nu[e] = 0.f; } }
        else { unpack8(*(const v4u*)pn_, ng_); unpack8(*(const v4u*)(pn_ + 128), nu); }
        float o[8];
#pragma unroll
        for (int h = 0; h < 2; ++h) {
            f32x4 wg[3], wu[3];
#pragma unroll
            for (int k = 0; k < 3; ++k) { wg[k] = *(const f32x4*)(cw + k * FF2 + a0 + 4 * h); wu[k] = *(const f32x4*)(cw + k * FF2 + FF + a0 + 4 * h); }
            const f32x4 bg = *(const f32x4*)(cb + a0 + 4 * h), bu = *(const f32x4*)(cb + FF + a0 + 4 * h);
#pragma unroll
            for (int j = 0; j < 4; ++j) { const int e = 4 * h + j;
                const float g = pg[e] * wg[0][j] + cg_[e] * wg[1][j] + ng_[e] * wg[2][j] + bg[j];
                const float u = pu[e] * wu[0][j] + cu[e] * wu[1][j] + nu[e] * wu[2][j] + bu[j];
                o[e] = g * __builtin_amdgcn_rcpf(1.0f + __builtin_amdgcn_exp2f(-1.4426950408889634f * g)) * u; }
        }
        v4u w; w.x = pk2(o[0], o[1]); w.y = pk2(o[2], o[3]); w.z = pk2(o[4], o[5]); w.w = pk2(o[6], o[7]);
        *(v4u*)(ACT + (size_t)lrow * FF + a0) = w;
    }
}

constexpr int SG_PITCH = 272;
__device__ __forceinline__ void sgu_prefetch_v(const bf16* Z, int rloc0, int grow0, int g, const float* vgain, const float* vstat, int tid, v4u (&v)[8], float (&st)[8], f32x4 (&vg)[2]) {
    const int db = tid & 31, qb = tid >> 5, d0 = 8 * db, q0 = 8 * qb;
#pragma unroll
    for (int i = 0; i < 8; ++i) { v[i] = *(const v4u*)(Z + (size_t)(rloc0 + q0 + i) * SGI2 + SGI + 256 * g + d0); st[i] = vstat[grow0 + q0 + i]; }
    vg[0] = *(const f32x4*)(vgain + 256 * g + d0); vg[1] = *(const f32x4*)(vgain + 256 * g + d0 + 4);
}
__device__ __forceinline__ void sgu_prefetch_u(const bf16* Z, int rloc0, int g, int tid, v4u (&uw)[8]) {
#pragma unroll
    for (int i = 0; i < 8; ++i) uw[i] = *(const v4u*)(Z + (size_t)(rloc0 + (tid >> 5) + 16 * i) * SGI2 + 256 * g + 8 * (tid & 31));
}
__device__ __forceinline__ void sgu_phase(LAS unsigned char* lds, bf16* Z, int r0, const bf16* wsb, const float* bs, const float* vgain, const float* vstat, int vcu, int G) {
    int tid_ = threadIdx.x; asm volatile("" : "+v"(tid_));
    const int tid = tid_, lane = tid & 63, wid = __builtin_amdgcn_readfirstlane(tid >> 6), fr = lane & 15, fq = lane >> 4;
    LAS unsigned char* ldsA = lds + 256 * SG_PITCH;
    v4u v[8]; float st[8]; v4u uw[8]; f32x4 vg[2];
    int u = vcu, g_staged = -1;
    constexpr int SP = 528;
    if (u < 1024) sgu_prefetch_v(Z, (u >> 3) * 128, r0 + (u >> 3) * 128, u & 7, vgain, vstat, tid, v, st, vg);
#pragma unroll 1
    for (; u < 1024; u += G) {
        const int g = u & 7, rloc0 = (u >> 3) * 128;
        sgu_prefetch_u(Z, rloc0, g, tid, uw);
        __syncthreads();
        {
            const int db = tid & 31, qb = tid >> 5, d0 = 8 * db;
            float rs[8];
#pragma unroll
            for (int i = 0; i < 8; ++i) rs[i] = __builtin_amdgcn_rsqf(st[i] * (1.0f / 2048.0f) + EPS);
#pragma unroll
            for (int kh = 0; kh < 2; ++kh) {
                float val[8][4];
#pragma unroll
                for (int i = 0; i < 8; ++i) { const unsigned w0 = kh ? v[i].z : v[i].x, w1 = kh ? v[i].w : v[i].y;
                    val[i][0] = bflo(w0) * rs[i] * vg[kh][0]; val[i][1] = bfhi(w0) * rs[i] * vg[kh][1]; val[i][2] = bflo(w1) * rs[i] * vg[kh][2]; val[i][3] = bfhi(w1) * rs[i] * vg[kh][3]; }
#pragma unroll
                for (int k = 0; k < 4; ++k) {
                    v4u o; o.x = pg8::cvt_pk_bf16(val[0][k], val[1][k]); o.y = pg8::cvt_pk_bf16(val[2][k], val[3][k]); o.z = pg8::cvt_pk_bf16(val[4][k], val[5][k]); o.w = pg8::cvt_pk_bf16(val[6][k], val[7][k]);
                    const int d = d0 + 4 * kh + k;
                    *(LAS v4u*)(lds + d * SG_PITCH + ((qb ^ (db & 15)) << 4)) = o;
                }
            }
            if (g != g_staged) { g_staged = g;
#pragma unroll
                for (int i = 0; i < 4; ++i) { const int e = tid + NTHR * i, p = e >> 4, ch = e & 15; *(LAS v4u*)(ldsA + p * SG_PITCH + (ch << 4)) = *(const v4u*)(wsb + (size_t)g * 16384 + (size_t)e * 8); } }
        }
        __syncthreads();
        { const int un = u + G; if (un < 1024) sgu_prefetch_v(Z, (un >> 3) * 128, r0 + (un >> 3) * 128, un & 7, vgain, vstat, tid, v, st, vg); }
        f32x4 acc[8][2];
#pragma unroll
        for (int mt = 0; mt < 8; ++mt)
#pragma unroll
            for (int nt = 0; nt < 2; ++nt) acc[mt][nt] = (f32x4){0.f, 0.f, 0.f, 0.f};
#pragma unroll
        for (int ks = 0; ks < 4; ++ks) {
            bf16x8 bfr[2];
#pragma unroll
            for (int nt = 0; nt < 2; ++nt) { const int d = 32 * wid + 16 * nt + fr; bfr[nt] = *(const LAS bf16x8*)(lds + d * SG_PITCH + ((((4 * ks + fq) ^ ((d >> 3) & 15))) << 4)); }
#pragma unroll
            for (int mt = 0; mt < 8; ++mt) {
                const bf16x8 afr = *(const LAS bf16x8*)(ldsA + (16 * mt + fr) * SG_PITCH + ((4 * ks + fq) << 4));
#pragma unroll
                for (int nt = 0; nt < 2; ++nt) acc[mt][nt] = __builtin_amdgcn_mfma_f32_16x16x32_bf16(bfr[nt], afr, acc[mt][nt], 0, 0, 0);
            }
        }
        __syncthreads();
#pragma unroll
        for (int mt = 0; mt < 8; ++mt) {
            const int p = 16 * mt + fr; const float b1 = bs[g * 128 + p];
#pragma unroll
            for (int nt = 0; nt < 2; ++nt) { const f32x4 sv = acc[mt][nt]; v2u o; o.x = pg8::cvt_pk_bf16(sv[0] + b1, sv[1] + b1); o.y = pg8::cvt_pk_bf16(sv[2] + b1, sv[3] + b1);
                *(LAS v2u*)(lds + p * SP + (32 * wid + 16 * nt + 4 * fq) * 2) = o; }
        }
        __syncthreads();
#pragma unroll
        for (int i = 0; i < 8; ++i) {
            const int row = (tid >> 5) + 16 * i; const v4u sw = *(const LAS v4u*)(lds + row * SP + (tid & 31) * 16); const v4u u4 = uw[i];
            v4u o; o.x = pg8::cvt_pk_bf16(bflo(u4.x) * bflo(sw.x), bfhi(u4.x) * bfhi(sw.x)); o.y = pg8::cvt_pk_bf16(bflo(u4.y) * bflo(sw.y), bfhi(u4.y) * bfhi(sw.y));
            o.z = pg8::cvt_pk_bf16(bflo(u4.z) * bflo(sw.z), bfhi(u4.z) * bfhi(sw.z)); o.w = pg8::cvt_pk_bf16(bflo(u4.w) * bflo(sw.w), bfhi(u4.w) * bfhi(sw.w));
            *(v4u*)(Z + (size_t)(rloc0 + row) * SGI2 + 256 * g + 8 * (tid & 31)) = o;
        }
    }
}

__global__ void __launch_bounds__(NTHR, 2) mk_fwd(Args a) {
    extern __shared__ __attribute__((aligned(16))) unsigned char lds_raw[];
    cg::grid_group grid = cg::this_grid();
    LAS unsigned char* lds = (LAS unsigned char*)lds_raw;
    const int tid = threadIdx.x, lane = tid & 63, wave = __builtin_amdgcn_readfirstlane(tid >> 6);
    const int G = gridDim.x, bx = blockIdx.x, vcu = (G % 8 == 0) ? (bx % 8) * (G / 8) + bx / 8 : bx;
    const int gw = vcu * NWAVES + wave, NGW = G * NWAVES;
    unsigned char* ws = a.ws;
    float* stat0 = (float*)(ws + WS_CTL); float* stat1 = stat0 + M_TOK; float* stat2 = stat1 + M_TOK; float* stat3 = stat2 + M_TOK; float* stat4 = stat3 + M_TOK;
    bf16* XN = (bf16*)(ws + WS_XN); bf16* BIG = (bf16*)(ws + WS_BIG);
    float* out = a.out;
    for (int u = tid; u < (LDS_BYTES - LDSCTL_OFF) / 4; u += NTHR) ((LAS unsigned*)(lds + LDSCTL_OFF))[u] = 0u;
    __syncthreads();
    XcdBarrier bar = xcd_barrier_post((unsigned*)(ws + WS_BARW), (volatile LAS unsigned*)(lds + MISC_OFF) + 8);
#define GSYNC() xcd_barrier(bar)

    p0_prologue(a, lds, gw, NGW, wave, lane);
    if (a.out == nullptr) grid.sync();
    GSYNC();
    { pg8::Gemm g{XN, (const bf16*)(ws + WS_WQKV), M_TOK, NQKV, 1024, 1024, 1024}; pg8::StaticOrder S; S.init(M_TOK, NQKV, G, bx);
      pg8::EpiQKV E{BIG, stat0, a.in[5], a.in[6]};
      pg8::gemm_phase<pg8::EpiQKV, pg8::StaticOrder, true, true>(lds, g, S, E); }
    GSYNC();
    { const attn_body::bf16* QKV = (const attn_body::bf16*)BIG;
      float mq = __builtin_fabsf(a.in[5][lane]), mk = __builtin_fabsf(a.in[6][lane]);
#pragma unroll
      for (int o = 1; o < 64; o <<= 1) { mq = __builtin_fmaxf(mq, __shfl_xor(mq, o)); mk = __builtin_fmaxf(mk, __shfl_xor(mk, o)); }
      const int nomax = __builtin_amdgcn_readfirstlane((mq * mk < 4.0f) ? 1 : 0);
#define ATT_LOOPS(NM) \
      for (int k = vcu * 4; k < 1024; k += G * 4) \
          for (int i = 0; i < 4; ++i) { const int u = k + i, bh = u >> 5, qb = u & 31, b = bh >> 4, h = bh & 15; const size_t row0 = (size_t)b * 8192; \
              const attn_body::bf16* Qu = QKV + (row0 + qb * 256) * NQKV + h * 64; const attn_body::bf16* Kh = QKV + row0 * NQKV + 1024 + (h >> 2) * 64; \
              attn_body::attn_unit<8, NM>(Qu, Kh, Kh + 256, (attn_body::bf16*)Qu, 128, (char*)lds_raw); } \
      for (int k = vcu * 4; k < 1024; k += G * 4) \
          for (int i = 0; i < 4; ++i) { const int u = k + i, bh = u >> 3, qb = u & 7, b = bh >> 4, h = bh & 15; const size_t row0 = (size_t)M_P + (size_t)b * 2048; \
              const attn_body::bf16* Qu = QKV + (row0 + qb * 256) * NQKV + h * 64; const attn_body::bf16* Kh = QKV + row0 * NQKV + 1024 + (h >> 2) * 64; \
              attn_body::attn_unit<8, NM>(Qu, Kh, Kh + 256, (attn_body::bf16*)Qu, 32, (char*)lds_raw); }
      if (nomax) { ATT_LOOPS(true) } else { ATT_LOOPS(false) }
#undef ATT_LOOPS
    }
    GSYNC();
    { pg8::Gemm g{BIG, (const bf16*)(ws + WS_WO), M_TOK, 1024, 1024, NQKV, 1024}; pg8::StaticOrder S; S.init(M_TOK, 1024, G, bx);
      pg8::EpiRes E{nullptr, nullptr, 0x7fffffff, nullptr, XN, stat1, 0, XN};
      pg8::gemm_phase<pg8::EpiRes, pg8::StaticOrder, true, true>(lds, g, S, E); }
    GSYNC();
#pragma unroll 1
    for (int layer = 0; layer < 2; ++layer) {
        if (layer == 1) {
#pragma unroll 1
            for (int hf = 0; hf < 2; ++hf) {
                const int r0 = hf * 16384;
                { pg8::Gemm g{XN + (size_t)r0 * 1024, (const bf16*)(ws + WS_WIN), 16384, SGI2, 1024, 1024, 1024}; pg8::StaticOrder S; S.init(16384, SGI2, G, bx);
                  pg8::EpiBf16S<2> E{BIG, SGI2, stat2, 1.0f / 1024.0f, r0, stat3, SGI};
                  pg8::gemm_phase<pg8::EpiBf16S<2>, pg8::StaticOrder, true, true>(lds, g, S, E); }
                GSYNC();
                sgu_phase(lds, BIG, r0, (const bf16*)(ws + WS_WS), a.in[11], a.in[9], stat3, vcu, G);
                GSYNC();
                { pg8::Gemm g{BIG, (const bf16*)(ws + WS_WOUT), 16384, 1024, SGI, SGI2, SGI}; pg8::StaticOrder S; S.init(16384, 1024, G, bx);
                  pg8::EpiRes E{nullptr, nullptr, 0x7fffffff, nullptr, XN, stat4, r0, XN};
                  pg8::gemm_phase<pg8::EpiRes, pg8::StaticOrder, true, true>(lds, g, S, E); }
                GSYNC();
            }
        }
        const bf16* Wup = (const bf16*)(ws + (layer ? WS_WUP1 : WS_WUP0)); const bf16* Wdn = (const bf16*)(ws + (layer ? WS_WDN1 : WS_WDN0));
        const float* st_in = layer ? stat4 : stat1;
        const float* cw = a.in[14] + (size_t)layer * 3 * FF2; const float* cb = a.in[15] + (size_t)layer * FF2;
        bf16* ACT = BIG; bf16* HALO = BIG + (size_t)16384 * FF;
#pragma unroll 1
        for (int hf = 0; hf < 2; ++hf) {
            const int r0 = hf * 16384;
            { pg8::Gemm g{XN + (size_t)r0 * 1024, Wup, 16384, FF2, 1024, 1024, 1024}; pg8::StaticOrder S; S.init(16384, FF2, G, bx);
              pg8::EpiConv E{ACT, HALO, st_in, r0, cw, cb};
              pg8::gemm_phase<pg8::EpiConv, pg8::StaticOrder, true, true>(lds, g, S, E); }
            if (layer == 0) {
                const bool spare = (G == 256) ? (bx >= 128) : true;
                if (spare) { const int nb = (G == 256) ? 128 : G, bi = (G == 256) ? bx - 128 : bx; p0_layer1_weights(a, lds, hf, bi * NWAVES + wave, nb * NWAVES, wave, lane); }
            }
            GSYNC();
            { pg8::Gemm g{ACT, Wdn, 16384, 1024, FF, FF, FF}; pg8::StaticOrder S; S.init(16384, 1024, G, bx);
              { pg8::Unit uu; for (int i = 0; S.next(i, uu); ++i) ffn_fixup(HALO, ACT, uu.pm, r0, cw, cb); }
              asm volatile("s_waitcnt vmcnt(0)" ::: "memory"); __syncthreads();
              if (layer == 0) { pg8::EpiRes E{nullptr, nullptr, 0x7fffffff, nullptr, XN, stat2, r0, XN};
                  pg8::gemm_phase<pg8::EpiRes, pg8::StaticOrder, true, true>(lds, g, S, E); }
              else { pg8::EpiResF E{nullptr, nullptr, 0x7fffffff, out, nullptr, nullptr, r0, XN};
                  pg8::gemm_phase<pg8::EpiResF, pg8::StaticOrder, true, true>(lds, g, S, E); } }
            if (!(layer == 1 && hf == 1)) GSYNC();
        }
    }
}

extern "C" void kernel_launch(void* const* d_in, const int* in_sizes, int n_in, void* d_out, int out_size, void* d_ws, size_t ws_size, hipStream_t stream) {
    static int grid = 0;
    if (grid == 0) {
        if (n_in != 17 || out_size != M_TOK * 1024 || ws_size < WS_END) { fprintf(stderr, "kernel_launch: unexpected shapes (n_in %d out %d ws %zu)\n", n_in, out_size, ws_size); grid = -1; return; }
        int dev = 0, cus = 0, per_cu = 0;
        if (hipGetDevice(&dev) != hipSuccess || hipDeviceGetAttribute(&cus, hipDeviceAttributeMultiprocessorCount, dev) != hipSuccess) { grid = -1; return; }
        if (hipFuncSetAttribute((const void*)mk_fwd, hipFuncAttributeMaxDynamicSharedMemorySize, LDS_BYTES) != hipSuccess) { fprintf(stderr, "kernel_launch: hipFuncSetAttribute failed\n"); grid = -1; return; }
        if (hipOccupancyMaxActiveBlocksPerMultiprocessor(&per_cu, (const void*)mk_fwd, NTHR, LDS_BYTES) != hipSuccess || per_cu < 1) { fprintf(stderr, "kernel_launch: occupancy query says %d\n", per_cu); per_cu = 1; }
        (void)hipGetLastError();
        grid = cus;
    }
    if (grid < 0) return;
    (void)hipMemsetAsync((char*)d_ws + WS_CTL, 0, CTL_BYTES, stream);
    Args a{};
    for (int i = 0; i < 17; ++i) a.in[i] = (const float*)d_in[i];
    a.out = (float*)d_out; a.ws = (unsigned char*)d_ws;
    void* args[] = {&a};
    hipError_t e = hipLaunchCooperativeKernel((const void*)mk_fwd, dim3(grid), dim3(NTHR), args, LDS_BYTES, stream);
    if (e != hipSuccess) fprintf(stderr, "kernel_launch: cooperative launch failed: %s (grid %d)\n", hipGetErrorString(e), grid);
}
```

```cpp
#include <hip/hip_runtime.h>
#include <hip/hip_cooperative_groups.h>
namespace cg = cooperative_groups;
#include <cstdio>
#include <cstdint>
namespace pg8 {
#define PG8_LAS __attribute__((address_space(3)))
typedef unsigned short bf16_t;
typedef short bf16x8 __attribute__((ext_vector_type(8)));
typedef float f32x4 __attribute__((ext_vector_type(4)));
typedef unsigned u32x4 __attribute__((ext_vector_type(4)));
constexpr int BM = 256, BK = 64, HALF = 128, HTB = HALF * BK * 2  , STAGE_BYTES = 8 * HTB, NXCD = 8, WGM = 8;

__host__ __device__ __forceinline__ int lds_byte(int r, int c) { const int st = (r >> 4) * 2 + (c >> 5), rr = r & 15, cc = c & 31, ob = rr * 64 + cc * 2; return st * 1024 + (ob ^ (((ob >> 9) & 1) << 5)); }
__host__ __device__ __forceinline__ void stage_rc(int b, int& R, int& C) { const int st = b / 1024, sb = b % 1024, swz = sb ^ (((sb >> 9) & 1) << 5); R = (st >> 1) * 16 + swz / 64; C = (st & 1) * 32 + (swz % 64) / 2; }
__host__ __device__ __forceinline__ int perm32(int rho) { const int n = rho >> 4, i = rho & 15; return 8 * (i >> 2) + 4 * n + (i & 3); }

struct Unit { int pm, pn; };
struct Gemm { const bf16_t* A; const bf16_t* Bt; int M, N, K, lda, ldb; };

struct StaticOrder {
    int nM, nN, nwg, G, c;
    __host__ __device__ __forceinline__ void init(int M, int N, int G_, int c_) { nM = M / BM; nN = N / BM; nwg = nM * nN; G = G_; c = c_; }
    __host__ __device__ __forceinline__ bool next(int i, Unit& u) const {
        const long L = (long)i * G + c; if (L >= nwg) return false;
        int wgid = (int)L; { const int q = nwg / NXCD, r = nwg % NXCD, xcd = wgid % NXCD, off = wgid / NXCD; wgid = (xcd < r ? xcd * (q + 1) : r * (q + 1) + (xcd - r) * q) + off; }
        const int nig = WGM * nN, gid = wgid / nig, fm = gid * WGM, gsz = (nM - fm) < WGM ? (nM - fm) : WGM;
        u.pm = fm + ((wgid % nig) % gsz); u.pn = (wgid % nig) / gsz; return true;
    }
    __device__ __forceinline__ void a_ready(const Unit&) const {}
    __device__ __forceinline__ void done(const Unit&) const {}
};

__device__ __forceinline__ unsigned cvt_pk_bf16(float lo, float hi) { unsigned r; asm volatile("v_cvt_pk_bf16_f32 %0, %1, %2" : "=v"(r) : "v"(lo), "v"(hi)); return r; }
typedef float f32x2 __attribute__((ext_vector_type(2)));
__device__ __forceinline__ float gelu_tanh(float x) { const float u = x * x * 0.044715f + 1.0f; const float e = __builtin_amdgcn_exp2f(-2.302208198f * x * u); return x * __builtin_amdgcn_rcpf(1.0f + e); }

template <int ACT> struct EpiBf16S {
    static constexpr bool PERM = true, AFTER_DRAIN = false, ROWPERM = false; static constexpr int NPARAM = 1;
    bf16_t* O; int ldc; const float* rstat; float rdim_inv; int row_off; float* vstat; int vcol0;
    __device__ __forceinline__ void stage_params(const Unit& u, PG8_LAS unsigned char* pbuf, int wr, int wc, int lane) const {
        asm volatile("" : "+v"(lane));
        if (lane < 32) { const float* gp = rstat + row_off + u.pm * BM + (lane >> 4) * HALF + wr * 64 + 4 * (lane & 15);
            __builtin_amdgcn_global_load_lds((const unsigned*)gp, (PG8_LAS unsigned*)pbuf, 16, 0, 0); }
    }
    __device__ __forceinline__ void operator()(const f32x4 (&acc)[2][2][4][2], const Unit& u, int wr, int wc, int fr, int fq, PG8_LAS unsigned char* pbuf) const {
        const int row0 = u.pm * BM + wr * 64 + fr, col0 = u.pn * BM + wc * 32 + 8 * fq;
        const bool dov = (vstat != nullptr) && (u.pn * BM >= vcol0);
        float ssv[2][4] = {{0.f, 0.f, 0.f, 0.f}, {0.f, 0.f, 0.f, 0.f}};
#pragma unroll
        for (int ai = 0; ai < 2; ++ai)
#pragma unroll
            for (int m = 0; m < 4; ++m) {
                const int r = row0 + ai * HALF + m * 16;
                const float sc = __builtin_amdgcn_rsqf(*(const PG8_LAS float*)(pbuf + (ai * 64 + m * 16 + fr) * 4) * rdim_inv + 1e-6f);
                bf16_t* rowp = O + (size_t)r * ldc + col0; float ss = 0.f;
#pragma unroll
                for (int bj = 0; bj < 2; ++bj) { f32x4 v0 = acc[ai][bj][m][0] * sc, v1 = acc[ai][bj][m][1] * sc;
                    if (ACT == 2) {
#pragma unroll
                        for (int j = 0; j < 4; ++j) { v0[j] = gelu_tanh(v0[j]); v1[j] = gelu_tanh(v1[j]); } }
                    if (dov) ss += (v0[0] * v0[0] + v0[1] * v0[1]) + (v0[2] * v0[2] + v0[3] * v0[3]) + (v1[0] * v1[0] + v1[1] * v1[1]) + (v1[2] * v1[2] + v1[3] * v1[3]);
                    u32x4 w; w.x = cvt_pk_bf16(v0[0], v0[1]); w.y = cvt_pk_bf16(v0[2], v0[3]); w.z = cvt_pk_bf16(v1[0], v1[1]); w.w = cvt_pk_bf16(v1[2], v1[3]);
                    *(u32x4*)(rowp + bj * HALF) = w; }
                if (dov) { ss += __shfl_xor(ss, 16); ss += __shfl_xor(ss, 32); ssv[ai][m] = ss; }
            }
        if (dov) {
#pragma unroll
            for (int ai = 0; ai < 2; ++ai) { const float v = (fq == 0) ? ssv[ai][0] : (fq == 1) ? ssv[ai][1] : (fq == 2) ? ssv[ai][2] : ssv[ai][3];
                atomicAdd(vstat + row_off + u.pm * BM + ai * HALF + wr * 64 + 16 * fq + fr, v); }
        }
    }
};

struct EpiRes {
    static constexpr int NPARAM = 0;
    static constexpr bool PERM = true, AFTER_DRAIN = false, ROWPERM = false;
    const float* base0; const float* base1; int split_row; float* out; bf16_t* xn; float* stat; int row_off; const bf16_t* bbase;
    __device__ __forceinline__ void operator()(const f32x4 (&acc)[2][2][4][2], const Unit& u, int wr, int wc, int fr, int fq, PG8_LAS unsigned char* pbuf) const {
        const int col0 = u.pn * BM + wc * 32 + 8 * fq;
        float ssv[2][4];
#pragma unroll
        for (int ai = 0; ai < 2; ++ai)
#pragma unroll
            for (int m = 0; m < 4; ++m) {
                const int r = row_off + u.pm * BM + ai * HALF + wr * 64 + m * 16 + fr;
                const float* b = (r < split_row) ? base0 + (size_t)r * 1024 : base1 + (size_t)(r - split_row) * 1024;
                float* o = out + (size_t)r * 1024; float ss = 0.f;
#pragma unroll
                for (int bj = 0; bj < 2; ++bj) { const int c = col0 + bj * HALF;
                    f32x4 b0, b1;
                    if (bbase) { const u32x4 w = *(const u32x4*)(bbase + (size_t)r * 1024 + c);
                        b0 = (f32x4){__builtin_bit_cast(float, w.x << 16), __builtin_bit_cast(float, w.x & 0xffff0000u), __builtin_bit_cast(float, w.y << 16), __builtin_bit_cast(float, w.y & 0xffff0000u)};
                        b1 = (f32x4){__builtin_bit_cast(float, w.z << 16), __builtin_bit_cast(float, w.z & 0xffff0000u), __builtin_bit_cast(float, w.w << 16), __builtin_bit_cast(float, w.w & 0xffff0000u)}; }
                    else { b0 = *(const f32x4*)(b + c); b1 = *(const f32x4*)(b + c + 4); }
                    const f32x4 x0 = b0 + acc[ai][bj][m][0], x1 = b1 + acc[ai][bj][m][1];
                    if (out) { *(f32x4*)(o + c) = x0; *(f32x4*)(o + c + 4) = x1; }
                    ss += (x0[0] * x0[0] + x0[1] * x0[1]) + (x0[2] * x0[2] + x0[3] * x0[3]) + (x1[0] * x1[0] + x1[1] * x1[1]) + (x1[2] * x1[2] + x1[3] * x1[3]);
                    if (xn) { u32x4 w; w.x = cvt_pk_bf16(x0[0], x0[1]); w.y = cvt_pk_bf16(x0[2], x0[3]); w.z = cvt_pk_bf16(x1[0], x1[1]); w.w = cvt_pk_bf16(x1[2], x1[3]); *(u32x4*)(xn + (size_t)r * 1024 + c) = w; } }
                ss += __shfl_xor(ss, 16); ss += __shfl_xor(ss, 32); ssv[ai][m] = ss;
                asm volatile("" ::: "memory");
            }
        if (stat) {
#pragma unroll
            for (int ai = 0; ai < 2; ++ai) { const float v = (fq == 0) ? ssv[ai][0] : (fq == 1) ? ssv[ai][1] : (fq == 2) ? ssv[ai][2] : ssv[ai][3];
                atomicAdd(stat + row_off + u.pm * BM + ai * HALF + wr * 64 + 16 * fq + fr, v); }
        }
    }
};

struct EpiResF {
    static constexpr bool PERM = false, AFTER_DRAIN = false, ROWPERM = false; static constexpr int NPARAM = 0;
    const float* base0; const float* base1; int split_row; float* out; bf16_t* xn; float* stat; int row_off; const bf16_t* bbase;
    __device__ __forceinline__ void operator()(const f32x4 (&acc)[2][2][4][2], const Unit& u, int wr, int wc, int fr, int fq, PG8_LAS unsigned char* pbuf) const {
        const int col0 = u.pn * BM + wc * 32 + 4 * fq;
#pragma unroll
        for (int ai = 0; ai < 2; ++ai)
#pragma unroll
            for (int m = 0; m < 4; ++m) {
                const int r = row_off + u.pm * BM + ai * HALF + wr * 64 + m * 16 + fr;
                const float* b = (r < split_row) ? base0 + (size_t)r * 1024 : base1 + (size_t)(r - split_row) * 1024;
                float* o = out + (size_t)r * 1024; float ss = 0.f;
#pragma unroll
                for (int bj = 0; bj < 2; ++bj)
#pragma unroll
                    for (int n = 0; n < 2; ++n) { const int c = col0 + bj * HALF + n * 16;
                        f32x4 bs;
                        if (bbase) { typedef unsigned u32x2w __attribute__((ext_vector_type(2))); const u32x2w w = *(const u32x2w*)(bbase + (size_t)r * 1024 + c);
                            bs = (f32x4){__builtin_bit_cast(float, w.x << 16), __builtin_bit_cast(float, w.x & 0xffff0000u), __builtin_bit_cast(float, w.y << 16), __builtin_bit_cast(float, w.y & 0xffff0000u)}; }
                        else bs = *(const f32x4*)(b + c);
                        const f32x4 x = bs + acc[ai][bj][m][n]; if (out) *(f32x4*)(o + c) = x;
                        ss += (x[0] * x[0] + x[1] * x[1]) + (x[2] * x[2] + x[3] * x[3]);
                        if (xn) { typedef unsigned u32x2v __attribute__((ext_vector_type(2))); u32x2v w; w.x = cvt_pk_bf16(x[0], x[1]); w.y = cvt_pk_bf16(x[2], x[3]); *(u32x2v*)(xn + (size_t)r * 1024 + c) = w; } }
                if (stat) { ss += __shfl_xor(ss, 16); ss += __shfl_xor(ss, 32); if (fq == 0) atomicAdd(stat + r, ss); }
                asm volatile("" ::: "memory");
            }
    }
};

__device__ __forceinline__ float dpp_shr1(float x) { return __builtin_bit_cast(float, __builtin_amdgcn_mov_dpp(__builtin_bit_cast(int, x), 0x111, 0xf, 0xf, true)); }
__device__ __forceinline__ float dpp_shl1(float x) { return __builtin_bit_cast(float, __builtin_amdgcn_mov_dpp(__builtin_bit_cast(int, x), 0x101, 0xf, 0xf, true)); }
__device__ __forceinline__ float dpp_ror1(float x)  { return __builtin_bit_cast(float, __builtin_amdgcn_mov_dpp(__builtin_bit_cast(int, x), 0x121, 0xf, 0xf, true)); }
__device__ __forceinline__ float dpp_ror15(float x) { return __builtin_bit_cast(float, __builtin_amdgcn_mov_dpp(__builtin_bit_cast(int, x), 0x12F, 0xf, 0xf, true)); }
struct EpiConv {
    static constexpr bool PERM = true, AFTER_DRAIN = false, ROWPERM = true;
    static constexpr int NPARAM = 1;
    bf16_t* ACT; bf16_t* HALO; const float* rstat; int row_off; const float* cw; const float* cb;
    __device__ __forceinline__ void stage_params(const Unit& u, PG8_LAS unsigned char* pbuf, int wr, int wc, int lane) const {
        asm volatile("" : "+v"(lane));
        const int cbase = u.pn * 128 + wc * 32;
        { const float* gp;
          if (lane < 32) gp = rstat + row_off + u.pm * BM + (lane >> 4) * HALF + wr * 64 + 4 * (lane & 15);
          else { const int j = lane - 32; gp = cw + (j >> 4) * 5632 + ((j >> 3) & 1) * 2816 + cbase + 4 * (j & 7); }
          __builtin_amdgcn_global_load_lds((const unsigned*)gp, (PG8_LAS unsigned*)pbuf, 16, 0, 0); }
        if (lane < 32) { const int j = lane; const float* gp = ((j >> 4) ? cb : cw + 2 * 5632) + ((j >> 3) & 1) * 2816 + cbase + 4 * (j & 7);
          __builtin_amdgcn_global_load_lds((const unsigned*)gp, (PG8_LAS unsigned*)(pbuf + 1024), 16, 0, 0); }
    }
    __device__ __forceinline__ void operator()(const f32x4 (&acc)[2][2][4][2], const Unit& u, int wr, int wc, int fr, int fq, PG8_LAS unsigned char* pbuf) const {
        const int a0 = u.pn * 128 + wc * 32 + 8 * fq, ng0 = u.pn * 256 + wc * 32 + 8 * fq;
        f32x4 wgA[2][3], wuA[2][3], bgA[2], buA[2], s4A[2];
#pragma unroll
        for (int ai = 0; ai < 2; ++ai) s4A[ai] = *(const PG8_LAS f32x4*)(pbuf + (ai * 64 + 4 * fr) * 4);
#pragma unroll
        for (int n = 0; n < 2; ++n) { const int cg4 = (2 * fq + n) * 16;
#pragma unroll
            for (int k = 0; k < 2; ++k) { wgA[n][k] = *(const PG8_LAS f32x4*)(pbuf + 512 + k * 256 + cg4); wuA[n][k] = *(const PG8_LAS f32x4*)(pbuf + 512 + k * 256 + 128 + cg4); }
            wgA[n][2] = *(const PG8_LAS f32x4*)(pbuf + 1024 + cg4); wuA[n][2] = *(const PG8_LAS f32x4*)(pbuf + 1024 + 128 + cg4);
            bgA[n] = *(const PG8_LAS f32x4*)(pbuf + 1280 + cg4); buA[n] = *(const PG8_LAS f32x4*)(pbuf + 1280 + 128 + cg4); }
#pragma unroll
        for (int ai = 0; ai < 2; ++ai) {
            const int R0 = u.pm * BM + ai * HALF + wr * 64;
            float sc[4];
            { const f32x4 s4 = s4A[ai];
#pragma unroll
              for (int m = 0; m < 4; ++m) sc[m] = __builtin_amdgcn_rsqf(s4[m] * (1.0f / 1024.0f) + 1e-6f); }
            if (fr == 0 || fr == 15) { bf16_t* hb = HALO + (size_t)(R0 >> 6) * 4 * 5632 + ng0;
#pragma unroll
              for (int bj = 0; bj < 2; ++bj)
#pragma unroll
                  for (int m = 0; m < 4; ++m) { const bool mine = (fr == 0) ? (m < 2) : (m >= 2);
                      if (mine) { const f32x4 v0 = acc[ai][bj][m][0] * sc[m], v1 = acc[ai][bj][m][1] * sc[m];
                          u32x4 w; w.x = cvt_pk_bf16(v0[0], v0[1]); w.y = cvt_pk_bf16(v0[2], v0[3]); w.z = cvt_pk_bf16(v1[0], v1[1]); w.w = cvt_pk_bf16(v1[2], v1[3]);
                          *(u32x4*)(hb + (size_t)m * 5632 + bj * HALF) = w; } } }
            unsigned ow[4][4];
#pragma unroll
            for (int n = 0; n < 2; ++n) {
                const f32x4 (&wg)[3] = wgA[n]; const f32x4 (&wu)[3] = wuA[n]; const f32x4 bg = bgA[n], bu = buA[n];
                float keep[4];
#pragma unroll
                for (int j = 0; j < 4; ++j) {
                    float xg[6], xu[6];
#pragma unroll
                    for (int m = 0; m < 4; ++m) { xg[m + 1] = acc[ai][0][m][n][j] * sc[m]; xu[m + 1] = acc[ai][1][m][n][j] * sc[m]; }
                    xg[0] = dpp_shr1(xg[4]); xg[5] = dpp_shl1(xg[1]); xu[0] = dpp_shr1(xu[4]); xu[5] = dpp_shl1(xu[1]);
#pragma unroll
                    for (int m = 0; m < 4; ++m) {
                        const float g = xg[m] * wg[0][j] + xg[m + 1] * wg[1][j] + xg[m + 2] * wg[2][j] + bg[j];
                        const float uu = xu[m] * wu[0][j] + xu[m + 1] * wu[1][j] + xu[m + 2] * wu[2][j] + bu[j];
                        const float av = g * __builtin_amdgcn_rcpf(1.0f + __builtin_amdgcn_exp2f(-1.4426950408889634f * g)) * uu;
                        if (j & 1) ow[m][2 * n + (j >> 1)] = cvt_pk_bf16(keep[m], av); else keep[m] = av;
                    }
                    __builtin_amdgcn_sched_barrier(0);
                }
            }
#pragma unroll
            for (int m = 0; m < 4; ++m) {
                u32x4 w; w.x = ow[m][0]; w.y = ow[m][1]; w.z = ow[m][2]; w.w = ow[m][3];
                const bool edge = (m == 0 && fr == 0) || (m == 3 && fr == 15);
                if (!edge) *(u32x4*)(ACT + (size_t)(R0 + 4 * fr + m) * 2816 + a0) = w;
            }
            asm volatile("" ::: "memory");
        }
    }
};

struct EpiQKV {
    static constexpr bool PERM = false, AFTER_DRAIN = false, ROWPERM = false; static constexpr int NPARAM = 0;
    bf16_t* O; const float* rstat; const float* qg; const float* kg;
    __device__ __forceinline__ void operator()(const f32x4 (&acc)[2][2][4][2], const Unit& u, int wr, int wc, int fr, int fq, PG8_LAS unsigned char* pbuf) const {
        typedef unsigned u32x2v __attribute__((ext_vector_type(2)));
        if (u.pn == 5) {
            const int col0 = 1280 + wc * 32 + 4 * fq;
#pragma unroll
            for (int ai = 0; ai < 2; ++ai)
#pragma unroll
                for (int m = 0; m < 4; ++m) { const int r = u.pm * BM + ai * HALF + wr * 64 + m * 16 + fr; const float sc = __builtin_amdgcn_rsqf(rstat[r] * (1.0f / 1024.0f) + 1e-6f);
#pragma unroll
                    for (int bj = 0; bj < 2; ++bj)
#pragma unroll
                        for (int n = 0; n < 2; ++n) { const f32x4 v = acc[ai][bj][m][n] * sc; u32x2v w; w.x = cvt_pk_bf16(v[0], v[1]); w.y = cvt_pk_bf16(v[2], v[3]);
                            *(u32x2v*)(O + (size_t)r * 1536 + col0 + bj * HALF + n * 16) = w; } }
            return;
        }
        const int head = u.pn * 4 + wc; const bool isq = u.pn < 4; const float* gp = isq ? qg : kg;
        f32x4 gn[2][2];
#pragma unroll
        for (int bj = 0; bj < 2; ++bj)
#pragma unroll
            for (int n = 0; n < 2; ++n) gn[bj][n] = *(const f32x4*)(gp + 32 * bj + 16 * n + 4 * fq);
        float invf[4];
#pragma unroll
        for (int j = 0; j < 4; ++j) invf[j] = __builtin_amdgcn_exp2f(-(float)(4 * fq + j) * 0.830482024f) * 0.15915494309189535f;
        const float osc = isq ? 0.125f * 1.4426950408889634f : 1.0f;
#pragma unroll
        for (int ai = 0; ai < 2; ++ai)
#pragma unroll
            for (int m = 0; m < 4; ++m) {
                const int r = u.pm * BM + ai * HALF + wr * 64 + m * 16 + fr; const float sc = __builtin_amdgcn_rsqf(rstat[r] * (1.0f / 1024.0f) + 1e-6f);
                f32x4 q[2][2]; float ss = 0.f;
#pragma unroll
                for (int bj = 0; bj < 2; ++bj)
#pragma unroll
                    for (int n = 0; n < 2; ++n) { q[bj][n] = acc[ai][bj][m][n] * sc; const f32x4 x = q[bj][n]; ss += (x[0] * x[0] + x[1] * x[1]) + (x[2] * x[2] + x[3] * x[3]); }
                ss += __shfl_xor(ss, 16); ss += __shfl_xor(ss, 32);
                const float rn = __builtin_amdgcn_rsqf(ss * (1.0f / 64.0f) + 1e-6f);
                const int t = (r < 16384) ? (r & 8191) : (r & 2047);
                bf16_t* op = O + (size_t)r * 1536 + head * 64 + 4 * fq;
#pragma unroll
                for (int bj = 0; bj < 2; ++bj) {
                    float pos = (float)(bj ? (t & 63) : (t >> 6)); asm volatile("" : "+v"(pos));
                    float oa[4], ob[4];
#pragma unroll
                    for (int j = 0; j < 4; ++j) {
                        float rev = pos * invf[j]; rev -= __builtin_floorf(rev);
                        const float sn = __builtin_amdgcn_sinf(rev), cs = __builtin_amdgcn_cosf(rev);
                        const float a = q[bj][0][j] * rn * gn[bj][0][j], b = q[bj][1][j] * rn * gn[bj][1][j];
                        oa[j] = (a * cs - b * sn) * osc; ob[j] = (b * cs + a * sn) * osc;
                    }
                    u32x2v wa, wb; wa.x = cvt_pk_bf16(oa[0], oa[1]); wa.y = cvt_pk_bf16(oa[2], oa[3]); wb.x = cvt_pk_bf16(ob[0], ob[1]); wb.y = cvt_pk_bf16(ob[2], ob[3]);
                    *(u32x2v*)(op + 32 * bj) = wa; *(u32x2v*)(op + 32 * bj + 16) = wb;
                    __builtin_amdgcn_sched_barrier(0);
                }
            }
    }
};
template <class Epi, class Sched, bool ALIGN_EPI = false, bool SP2 = false>
__device__ __forceinline__ void gemm_phase(PG8_LAS unsigned char* lds, Gemm g, const Sched& S, const Epi& E) {
    int tid_ = threadIdx.x; asm volatile("" : "+v"(tid_));
    asm volatile("" : "+s"(g.A), "+s"(g.Bt));
    const int tid = tid_, wid = __builtin_amdgcn_readfirstlane(tid >> 6), lane = tid & 63, wr = wid >> 2, wc = wid & 3, fr = lane & 15, fq = lane >> 4;
    const int K = g.K, nt = K / BK;
    unsigned voffA[2], voffB[2];
#pragma unroll
    for (int i = 0; i < 2; ++i) { int R, C; stage_rc(tid * 16 + i * 8192, R, C); const int Rb = Epi::PERM ? ((R & ~31) + perm32(R & 31)) : R;
        const int Ra = Epi::ROWPERM ? ((R & ~63) + 4 * (R & 15) + ((R >> 4) & 3)) : R;
        voffA[i] = (unsigned)(Ra * g.lda + C) * 2u; voffB[i] = (unsigned)(Rb * g.ldb + C) * 2u; }
    const size_t kstep = (size_t)(BK * 2);
    const size_t hstepA = (size_t)HALF * g.lda * 2, hstepB = (size_t)HALF * g.ldb * 2;
    const size_t tstepA = 2 * hstepA, tstepB = 2 * hstepB;
    const unsigned ldsw = (unsigned)wid * 1024u;
    const int aoff = lds_byte(wr * 64 + fr, fq * 8), boff = lds_byte(wc * 32 + fr, fq * 8);
#define PG8_SA(b, h) (((b) * 2 + (h)) * HTB)
#define PG8_SB(b, h) ((4 + (b) * 2 + (h)) * HTB)
#define PG8_STAGE(bufoff, gbase, voff) do { _Pragma("unroll") for (int _i = 0; _i < 2; ++_i) \
        __builtin_amdgcn_global_load_lds((const unsigned*)((const char*)(gbase) + (voff)[_i]), (PG8_LAS unsigned*)(lds + (bufoff) + ldsw + _i * 8192), 16, 0, 0); } while (0)
#define PG8_LDA(dst, b, h) do { _Pragma("unroll") for (int m = 0; m < 4; ++m) _Pragma("unroll") for (int k = 0; k < 2; ++k) dst[m][k] = *(const PG8_LAS bf16x8*)(lds + PG8_SA(b, h) + aoff + m * 2048 + k * 1024); } while (0)
#define PG8_LDB(dst, b, h) do { _Pragma("unroll") for (int n = 0; n < 2; ++n) _Pragma("unroll") for (int k = 0; k < 2; ++k) dst[n][k] = *(const PG8_LAS bf16x8*)(lds + PG8_SB(b, h) + boff + n * 2048 + k * 1024); } while (0)
#define PG8_MMA(ai, bj, At, Bt) do { __builtin_amdgcn_s_setprio(1); _Pragma("unroll") for (int m = 0; m < 4; ++m) _Pragma("unroll") for (int n = 0; n < 2; ++n) _Pragma("unroll") for (int k = 0; k < 2; ++k) \
        acc[ai][bj][m][n] = __builtin_amdgcn_mfma_f32_16x16x32_bf16(Bt[n][k], At[m][k], acc[ai][bj][m][n], 0, 0, 0); __builtin_amdgcn_s_setprio(0); } while (0)
#define PG8_WAIT_V(n) asm volatile("s_waitcnt vmcnt(" #n ")" ::: "memory")
#define PG8_WAIT_L(n) asm volatile("s_waitcnt lgkmcnt(" #n ")" ::: "memory")
#define PG8_BAR __builtin_amdgcn_s_barrier()
#define PG8_SCHED __builtin_amdgcn_sched_barrier(0)
    Unit cur, nxt; int ui = 0;
    constexpr int PBLK_OFF = STAGE_BYTES + 1024, PBLK_WAVE = 1536, PBLK_ALL = 8 * PBLK_WAVE;
    PG8_LAS unsigned char* const pblk = lds + PBLK_OFF + wid * PBLK_WAVE; int upar = 0;
    if (!S.next(0, cur)) return;
    f32x4 acc[2][2][4][2];
#pragma unroll
    for (int a = 0; a < 2; ++a)
#pragma unroll
        for (int b = 0; b < 2; ++b)
#pragma unroll
            for (int m = 0; m < 4; ++m)
#pragma unroll
                for (int n = 0; n < 2; ++n) acc[a][b][m][n] = (f32x4){0.f, 0.f, 0.f, 0.f};
    bf16x8 At[4][2], B0[2][2], B1[2][2];
    const char* cA = (const char*)g.A + (size_t)cur.pm * tstepA; const char* cB = (const char*)g.Bt + (size_t)cur.pn * tstepB;
    S.a_ready(cur);
    if constexpr (Epi::NPARAM > 0) E.stage_params(cur, pblk, wr, wc, lane);
    if constexpr (SP2) {
        PG8_STAGE(PG8_SB(0, 0), cB, voffB); PG8_STAGE(PG8_SB(0, 1), cB + hstepB, voffB); PG8_STAGE(PG8_SA(0, 0), cA, voffA); PG8_STAGE(PG8_SA(0, 1), cA + hstepA, voffA);
        if (wr == 1) PG8_BAR;
        PG8_WAIT_V(2); PG8_BAR;
        PG8_STAGE(PG8_SB(1, 0), cB + kstep, voffB); PG8_STAGE(PG8_SA(1, 0), cA + kstep, voffA); PG8_STAGE(PG8_SB(1, 1), cB + hstepB + kstep, voffB);
        PG8_WAIT_V(6); PG8_BAR;
    } else {
        PG8_STAGE(PG8_SB(0, 0), cB, voffB); PG8_STAGE(PG8_SA(0, 0), cA, voffA); PG8_STAGE(PG8_SB(0, 1), cB + hstepB, voffB); PG8_STAGE(PG8_SA(0, 1), cA + hstepA, voffA);
        if (wr == 1) PG8_BAR;
        PG8_WAIT_V(4); PG8_BAR;
        PG8_STAGE(PG8_SB(1, 0), cB + kstep, voffB); PG8_STAGE(PG8_SA(1, 0), cA + kstep, voffA); PG8_STAGE(PG8_SB(1, 1), cB + hstepB + kstep, voffB);
        PG8_WAIT_V(6); PG8_BAR;
    }
    for (;;) {
        const bool has_next = S.next(ui + 1, nxt);
        const char* nA = has_next ? (const char*)g.A + (size_t)nxt.pm * tstepA : cA; const char* nB = has_next ? (const char*)g.Bt + (size_t)nxt.pn * tstepB : cB;
        for (int t = 0; t < nt; t += 2) {
            const bool last = (t == nt - 2);
            const char* a1 = cA + (size_t)(t + 1) * kstep;
            const char* a2 = last ? nA : cA + (size_t)(t + 2) * kstep; const char* b2 = last ? nB : cB + (size_t)(t + 2) * kstep;
            const char* a3 = a2 + kstep; const char* b3 = b2 + kstep;
            if (last && has_next) S.a_ready(nxt);
            if constexpr (SP2) {
            PG8_LDB(B0, 0, 0); PG8_LDB(B1, 0, 1); PG8_SCHED; PG8_LDA(At, 0, 0); PG8_STAGE(PG8_SA(1, 1), a1 + hstepA, voffA);
            PG8_WAIT_V(8); PG8_WAIT_L(0); PG8_BAR; PG8_MMA(0, 0, At, B0); PG8_MMA(0, 1, At, B1); PG8_BAR; PG8_SCHED;
            PG8_LDA(At, 0, 1); PG8_STAGE(PG8_SB(0, 0), b2, voffB); PG8_STAGE(PG8_SB(0, 1), b2 + hstepB, voffB); PG8_STAGE(PG8_SA(0, 0), a2, voffA);
            PG8_WAIT_V(8); PG8_WAIT_L(0); PG8_BAR; PG8_MMA(1, 0, At, B0); PG8_MMA(1, 1, At, B1); PG8_BAR; PG8_SCHED;
            PG8_LDB(B0, 1, 0); PG8_LDB(B1, 1, 1); PG8_SCHED; PG8_LDA(At, 1, 0); PG8_STAGE(PG8_SA(0, 1), a2 + hstepA, voffA);
            PG8_WAIT_V(8); PG8_WAIT_L(0); PG8_BAR; PG8_MMA(0, 0, At, B0); PG8_MMA(0, 1, At, B1); PG8_BAR; PG8_SCHED;
            PG8_LDA(At, 1, 1); PG8_STAGE(PG8_SB(1, 0), b3, voffB); PG8_STAGE(PG8_SB(1, 1), b3 + hstepB, voffB); PG8_STAGE(PG8_SA(1, 0), a3, voffA);
            PG8_WAIT_V(8); PG8_WAIT_L(0); PG8_BAR; PG8_MMA(1, 0, At, B0); PG8_MMA(1, 1, At, B1); PG8_BAR; PG8_SCHED;
            } else {
            PG8_LDB(B0, 0, 0); PG8_SCHED; PG8_LDA(At, 0, 0); PG8_STAGE(PG8_SA(1, 1), a1 + hstepA, voffA);
            PG8_WAIT_L(8); PG8_BAR; PG8_WAIT_L(0); PG8_MMA(0, 0, At, B0); PG8_BAR; PG8_SCHED;
            PG8_LDB(B1, 0, 1); PG8_STAGE(PG8_SB(0, 0), b2, voffB);
            PG8_BAR; PG8_WAIT_L(0); PG8_MMA(0, 1, At, B1); PG8_BAR;
            PG8_LDA(At, 0, 1); PG8_STAGE(PG8_SA(0, 0), a2, voffA);
            PG8_BAR; PG8_WAIT_L(0); PG8_MMA(1, 0, At, B0); PG8_BAR; PG8_SCHED;
            PG8_STAGE(PG8_SB(0, 1), b2 + hstepB, voffB);
            PG8_WAIT_V(6); PG8_BAR; PG8_MMA(1, 1, At, B1); PG8_BAR;
            PG8_LDB(B0, 1, 0); PG8_SCHED; PG8_LDA(At, 1, 0); PG8_STAGE(PG8_SA(0, 1), a2 + hstepA, voffA);
            PG8_WAIT_L(8); PG8_BAR; PG8_WAIT_L(0); PG8_MMA(0, 0, At, B0); PG8_BAR; PG8_SCHED;
            PG8_LDB(B1, 1, 1); PG8_STAGE(PG8_SB(1, 0), b3, voffB);
            PG8_BAR; PG8_WAIT_L(0); PG8_MMA(0, 1, At, B1); PG8_BAR;
            PG8_LDA(At, 1, 1); PG8_STAGE(PG8_SA(1, 0), a3, voffA);
            PG8_BAR; PG8_WAIT_L(0); PG8_MMA(1, 0, At, B0); PG8_BAR; PG8_SCHED;
            PG8_STAGE(PG8_SB(1, 1), b3 + hstepB, voffB);
            PG8_WAIT_V(6); PG8_BAR; PG8_MMA(1, 1, At, B1); PG8_BAR;
            }
        }
        if constexpr (ALIGN_EPI) { if (wr == 0) PG8_BAR; }
        if constexpr (!Epi::AFTER_DRAIN) { int fr_e = fr, fq_e = fq; asm volatile("" : "+v"(fr_e), "+v"(fq_e));
            E(acc, cur, wr, wc, fr_e, fq_e, pblk + upar * PBLK_ALL); upar ^= 1; S.done(cur);
            if constexpr (Epi::NPARAM > 0) { if (has_next) E.stage_params(nxt, pblk + upar * PBLK_ALL, wr, wc, (fq_e << 4) | fr_e); } }
        if (!has_next) break;
#pragma unroll
        for (int a = 0; a < 2; ++a)
#pragma unroll
            for (int b = 0; b < 2; ++b)
#pragma unroll
                for (int m = 0; m < 4; ++m)
#pragma unroll
                    for (int n = 0; n < 2; ++n) acc[a][b][m][n] = (f32x4){0.f, 0.f, 0.f, 0.f};
        cur = nxt; cA = nA; cB = nB; ++ui;
        if constexpr (ALIGN_EPI) { if (wr == 1) PG8_BAR; }
    }
    PG8_WAIT_V(0);
    if constexpr (!ALIGN_EPI) { if (wr == 0) PG8_BAR; }
    PG8_BAR;
    if constexpr (Epi::AFTER_DRAIN) { E.fused(acc, cur, wr, wc, fr, fq, lds, wid, lane); S.done(cur); }
#undef PG8_SA
#undef PG8_SB
#undef PG8_STAGE
#undef PG8_LDA
#undef PG8_LDB
#undef PG8_MMA
#undef PG8_WAIT_V
#undef PG8_WAIT_L
#undef PG8_BAR
#undef PG8_SCHED
}
}
#include <hip/hip_bf16.h>
#include <cmath>
namespace attn_body {
using bf16=__hip_bfloat16;
using bf16x8=__attribute__((ext_vector_type(8)))short;
using s16x4=__attribute__((ext_vector_type(4)))short;
using f32x16=__attribute__((ext_vector_type(16)))float;
using u32x4=__attribute__((ext_vector_type(4)))unsigned;
constexpr int D=64,DM=1536;
constexpr int NW=8,QBLK=32,QB=QBLK*NW,KVBLK=64;
constexpr int ATTN_PITCH=DM, ATTN_UNIT_ROWS=QB;
__device__ __forceinline__ int crow(int r,int hi){return (r&3)+8*(r>>2)+4*hi;}
#define SBAR() __builtin_amdgcn_sched_barrier(0)
__device__ __forceinline__ void cmask(f32x16&p0,f32x16&p1,int jb,int qrel,int hi){
  const float NEG=-INFINITY; int kb=64*jb+4*hi;
  #pragma unroll
  for(int r=0;r<16;++r){int kv=kb+(r&3)+8*(r>>2); if(kv>qrel)p0[r]=NEG; if(kv+32>qrel)p1[r]=NEG;}
}

constexpr int NSLOT=3, SLOTB=8192;
constexpr int LDS_K=0, LDS_V=NSLOT*SLOTB, LDS_WS=2*NSLOT*SLOTB, LDS_OST=LDS_WS+NW*64*4, LDS_BYTES=LDS_OST+NW*4096;
constexpr float C2=0.125f*1.4426950408889634f;
__device__ __forceinline__ void glds16(const void*gsrc,unsigned lds_dst){unsigned keep;
  asm volatile("s_mov_b32 %0, m0\n\ts_mov_b32 m0, %2\n\ts_nop 0\n\tglobal_load_lds_dwordx4 %1, off\n\ts_mov_b32 m0, %0":"=&s"(keep):"v"(gsrc),"s"(lds_dst):"memory");}
__device__ __forceinline__ float max3f(float a,float b,float c){float r;asm("v_max3_f32 %0, %1, %2, %3":"=v"(r):"v"(a),"v"(b),"v"(c));return r;}
__device__ __forceinline__ float max2f(float a,float b){float r;asm("v_max_f32_e32 %0, %1, %2":"=v"(r):"v"(a),"v"(b));return r;}
__device__ __forceinline__ float fadd_s(float a,float b){float r;asm("v_add_f32_e32 %0, %1, %2":"=v"(r):"v"(a),"v"(b));return r;}
__device__ __forceinline__ float fsub_s(float a,float b){float r;asm("v_sub_f32_e32 %0, %1, %2":"=v"(r):"v"(a),"v"(b));return r;}
typedef float f32x2_t __attribute__((ext_vector_type(2))); typedef __bf16 bf16x2_t __attribute__((ext_vector_type(2)));
__device__ __forceinline__ unsigned cvtpk_s(float lo,float hi){f32x2_t v={lo,hi};bf16x2_t b=__builtin_convertvector(v,bf16x2_t);return __builtin_bit_cast(unsigned,b);}
#define WAIT_BAR(N) asm volatile("s_waitcnt vmcnt(" #N ") lgkmcnt(0)\n\ts_barrier":::"memory")

__device__ __forceinline__ void qkt(f32x16&p0,f32x16&p1,const char*Kslot,const bf16x8*qr,const f32x16&negm,int r32,int hi){
  const char*kb=Kslot+hi*1024+r32*16;
  #pragma unroll
  for(int d0=0;d0<4;++d0){
    const bf16x8 b0=*reinterpret_cast<const bf16x8*>(kb+d0*2048);
    const bf16x8 b1=*reinterpret_cast<const bf16x8*>(kb+d0*2048+512);
    if(d0==0){p0=__builtin_amdgcn_mfma_f32_32x32x16_bf16(b0,qr[0],negm,0,0,0);p1=__builtin_amdgcn_mfma_f32_32x32x16_bf16(b1,qr[0],negm,0,0,0);}
    else{p0=__builtin_amdgcn_mfma_f32_32x32x16_bf16(b0,qr[d0],p0,0,0,0);p1=__builtin_amdgcn_mfma_f32_32x32x16_bf16(b1,qr[d0],p1,0,0,0);}}
}
typedef __attribute__((address_space(3))) const char* lds_cptr;
typedef short v4i16_t __attribute__((ext_vector_type(4)));
__device__ __forceinline__ void kload8(bf16x8*kf,lds_cptr kp){
  kf[0]=*(const __attribute__((address_space(3))) bf16x8*)(kp);      kf[1]=*(const __attribute__((address_space(3))) bf16x8*)(kp+512);
  kf[2]=*(const __attribute__((address_space(3))) bf16x8*)(kp+2048); kf[3]=*(const __attribute__((address_space(3))) bf16x8*)(kp+2560);
  kf[4]=*(const __attribute__((address_space(3))) bf16x8*)(kp+4096); kf[5]=*(const __attribute__((address_space(3))) bf16x8*)(kp+4608);
  kf[6]=*(const __attribute__((address_space(3))) bf16x8*)(kp+6144); kf[7]=*(const __attribute__((address_space(3))) bf16x8*)(kp+6656);
}
__device__ __forceinline__ void kload2(bf16x8*kf,lds_cptr kp,int j){ kf[2*j]=*(const __attribute__((address_space(3))) bf16x8*)(kp+j*2048); kf[2*j+1]=*(const __attribute__((address_space(3))) bf16x8*)(kp+j*2048+512); }
__device__ __forceinline__ s16x4 vtr(lds_cptr p){ return __builtin_bit_cast(s16x4,__builtin_amdgcn_ds_read_tr16_b64_v4i16((__attribute__((address_space(3))) v4i16_t*)p)); }
__device__ __forceinline__ float rowmax(const f32x16&p0,const f32x16&p1){
  float a=max3f(p0[0],p0[1],p1[0]),b=max3f(p0[2],p0[3],p1[1]);a=max3f(a,p1[2],p1[3]);
  #pragma unroll
  for(int r=4;r<16;r+=4){a=max3f(a,p0[r],p0[r+1]);b=max3f(b,p0[r+2],p0[r+3]);a=max3f(a,p1[r],p1[r+1]);b=max3f(b,p1[r+2],p1[r+3]);}
  const float m=max2f(a,b);
  auto rr=__builtin_amdgcn_permlane32_swap(__float_as_uint(m),__float_as_uint(m),false,false);
  return max2f(__uint_as_float(rr[0]),__uint_as_float(rr[1]));
}
__device__ __forceinline__ void pv(f32x16*o,int vb,bf16x8 pa0,bf16x8 pa1,bf16x8 pa2,bf16x8 pa3){
  #pragma unroll
  for(int d0=0;d0<2;++d0){s16x4 lo[4],hi[4];
    #pragma unroll
    for(int ks=0;ks<4;++ks){
      asm volatile("ds_read_b64_tr_b16 %0,%1 offset:%c2":"=&v"(lo[ks]):"v"(vb),"i"(d0*4096+ks*1024):"memory");
      asm volatile("ds_read_b64_tr_b16 %0,%1 offset:%c2":"=&v"(hi[ks]):"v"(vb),"i"(d0*4096+ks*1024+512):"memory");}
    asm volatile("s_waitcnt lgkmcnt(0)":::"memory");SBAR();
    #define PK(k) (bf16x8){lo[k][0],lo[k][1],lo[k][2],lo[k][3],hi[k][0],hi[k][1],hi[k][2],hi[k][3]}
    o[d0]=__builtin_amdgcn_mfma_f32_32x32x16_bf16(pa0,PK(0),o[d0],0,0,0);
    o[d0]=__builtin_amdgcn_mfma_f32_32x32x16_bf16(pa1,PK(1),o[d0],0,0,0);
    o[d0]=__builtin_amdgcn_mfma_f32_32x32x16_bf16(pa2,PK(2),o[d0],0,0,0);
    o[d0]=__builtin_amdgcn_mfma_f32_32x32x16_bf16(pa3,PK(3),o[d0],0,0,0);
    #undef PK
  }
}

#ifndef ATTN_STORE16
#define ATTN_STORE16(p,v) (*(u32x4*)(p)=(v))
#endif
template<int THRL, bool NOMAX> __device__ __forceinline__ void attn_unit(const bf16*Qu,const bf16*__restrict__ Kh,const bf16*__restrict__ Vh,bf16*Ou,const int NT,char*shm){
  const int tid=threadIdx.x,lane=tid&63,r32=lane&31,hi=lane>>5; const int wid=__builtin_amdgcn_readfirstlane(tid>>6);
  const bf16*Qw=Qu+(long)(wid*QBLK)*DM;
  const unsigned lds0=(unsigned)(uintptr_t)shm;
  float*wsf=(float*)(shm+LDS_WS)+wid*64;
  const bf16*ksrc=Kh+(long)lane*DM+wid*8;
  const bf16*vsrc=Vh+(long)(16*(wid&3)+(lane>>2))*DM+(wid>>2)*32+(lane&3)*8;
  const unsigned kdst=lds0+LDS_K+wid*1024, vdst=lds0+LDS_V+wid*1024;
  #define DMA_K(t,slot) glds16(ksrc+(long)(t)*KVBLK*DM,(unsigned)__builtin_amdgcn_readfirstlane(kdst+(slot)))
  #define DMA_V(t,slot) glds16(vsrc+(long)(t)*KVBLK*DM,(unsigned)__builtin_amdgcn_readfirstlane(vdst+(slot)))
  const int vb0=(int)(lds0+LDS_V)+((lane>>4)&1)*32+(lane&3)*8+(4*hi+((lane&15)>>2))*64;
  const char*Kbase=shm+LDS_K; bf16x8 kf[8];
  const lds_cptr shm3=(lds_cptr)shm; const lds_cptr kp0=shm3+LDS_K+hi*1024+r32*16; const lds_cptr vp0=shm3+LDS_V+((lane>>4)&1)*32+(lane&3)*8+(4*hi+((lane&15)>>2))*64;
  DMA_K(0,0);DMA_V(0,0);DMA_K(1,SLOTB);
  bf16x8 qr[4];
  #pragma unroll
  for(int d0=0;d0<4;++d0)qr[d0]=*reinterpret_cast<const bf16x8*>(&Qw[(long)r32*DM+d0*16+hi*8]);
  float mhat=0.f,l_reg=0.f;f32x16 o[2];o[0]=f32x16{};o[1]=f32x16{};f32x16 negm=f32x16{};asm volatile("":"+v"(negm));
  const int qrel=wid*QBLK+r32;
  #define CMASK(P0,P1,t) do{}while(0)
  bool resc=false;
  #define START(P0,P1) do{ const float rm=rowmax(P0,P1); resc=false; \
    { const float dl=rm; mhat=fadd_s(mhat,dl); \
      _Pragma("unroll") for(int r=0;r<16;++r){P0[r]=fsub_s(P0[r],dl);P1[r]=fsub_s(P1[r],dl);} \
      _Pragma("unroll") for(int r=0;r<16;++r)negm[r]=-mhat; asm volatile("":"+v"(negm)); } \
    _Pragma("unroll") for(int r=0;r<16;++r)P0[r]=__builtin_amdgcn_exp2f(P0[r]); }while(0)
  #define RESC() do{ if(resc){ asm volatile("s_waitcnt lgkmcnt(0)":::"memory"); \
      _Pragma("unroll") for(int d_=0;d_<2;++d_) _Pragma("unroll") for(int r=0;r<16;++r)o[d_][r]*=wsf[crow(r,hi)]; } }while(0)
  f32x16 pA0,pA1,pB0,pB1;
  int sl_prev=0,sl_cur=0,sl_next=SLOTB;
  #define ROT() do{sl_prev=sl_cur;sl_cur=sl_next;sl_next=(sl_next==(NSLOT-1)*SLOTB)?0:sl_next+SLOTB;}while(0)
  DMA_K(2,2*SLOTB);
  WAIT_BAR(3);
  qkt(pA0,pA1,Kbase,qr,negm,r32,hi);asm volatile("s_nop 15\n\ts_nop 7":"+v"(pA0),"+v"(pA1));CMASK(pA0,pA1,0);
  START(pA0,pA1);
  _Pragma("unroll") for(int r=0;r<16;++r)pA1[r]=__builtin_amdgcn_exp2f(pA1[r]);
  WAIT_BAR(0);
  DMA_K(3,0);DMA_V(1,SLOTB);
  ROT();
  kload8(kf,kp0+sl_cur);
  WAIT_BAR(2);
  s16x4 vlo[8],vhi[8]; u32x4 pw0,pw1,pw2,pw3;
  #define PKW(P,B) cvtpk_s(P[B],P[B+1])
  #define PAF(k) __builtin_bit_cast(bf16x8,pw##k)
  #define VFR(i) (bf16x8){vlo[i][0],vlo[i][1],vlo[i][2],vlo[i][3],vhi[i][0],vhi[i][1],vhi[i][2],vhi[i][3]}
  #define PIN(x) asm volatile("":"+v"(x))
  #define MX3(a,b,c) __builtin_fmaxf(__builtin_fmaxf((a),(b)),(c))
  #define GAPA(MF,A0,A1,A2,A3,W0,W1,PW) do{ MF; sacc+=A0; sacc+=A1; sacc+=A2; sacc+=A3; PIN(sacc); W0; W1; PIN(PW); SBAR(); }while(0)
  #define EX(v) __builtin_amdgcn_exp2f(v)
  #define GAPB(MF,X,B) do{ MF; X[B]=EX(X[B]); X[B+1]=EX(X[B+1]); X[B+2]=EX(X[B+2]); X[B+3]=EX(X[B+3]); PIN(X); SBAR(); }while(0)
  #define VRD(i) do{ vlo[i]=vtr(vp_+(((i)>>2)*4096+((i)&3)*1024)); vhi[i]=vtr(vp_+(((i)>>2)*4096+((i)&3)*1024+512)); }while(0)
  #define KRD(G,j) do{ if(G){ kload2(kf,kp0+sl_next,j); SBAR(); } }while(0)
  #define STEP(C0,C1,P0,P1,t,GK,GV,GL) do{ SBAR(); \
    const lds_cptr vp_=vp0+sl_prev; \
    VRD(0); SBAR(); float sacc=(P0[0]+P0[1]); \
    GAPA(C0=__builtin_amdgcn_mfma_f32_32x32x16_bf16(kf[0],qr[0],negm,0,0,0), P0[2],P0[3],P0[4],P0[5],     pw0[0]=PKW(P0,0), pw0[1]=PKW(P0,2), pw0); \
    VRD(4); SBAR(); GAPA(C1=__builtin_amdgcn_mfma_f32_32x32x16_bf16(kf[1],qr[0],negm,0,0,0), P0[6],P0[7],P0[8],P0[9],     pw0[2]=PKW(P0,4), pw0[3]=PKW(P0,6), pw0); \
    VRD(1); SBAR(); GAPA(C0=__builtin_amdgcn_mfma_f32_32x32x16_bf16(kf[2],qr[1],C0,0,0,0),   P0[10],P0[11],P0[12],P0[13], pw1[0]=PKW(P0,8), pw1[1]=PKW(P0,10), pw1); \
    VRD(5); SBAR(); GAPA(C1=__builtin_amdgcn_mfma_f32_32x32x16_bf16(kf[3],qr[1],C1,0,0,0),   P0[14],P0[15],P1[0],P1[1],   pw1[2]=PKW(P0,12),pw1[3]=PKW(P0,14), pw1); \
    VRD(2); SBAR(); GAPA(C0=__builtin_amdgcn_mfma_f32_32x32x16_bf16(kf[4],qr[2],C0,0,0,0),   P1[2],P1[3],P1[4],P1[5],     pw2[0]=PKW(P1,0), pw2[1]=PKW(P1,2), pw2); \
    VRD(6); SBAR(); GAPA(C1=__builtin_amdgcn_mfma_f32_32x32x16_bf16(kf[5],qr[2],C1,0,0,0),   P1[6],P1[7],P1[8],P1[9],     pw2[2]=PKW(P1,4), pw2[3]=PKW(P1,6), pw2); \
    VRD(3); SBAR(); GAPA(C0=__builtin_amdgcn_mfma_f32_32x32x16_bf16(kf[6],qr[3],C0,0,0,0),   P1[10],P1[11],P1[12],P1[13], pw3[0]=PKW(P1,8), pw3[1]=PKW(P1,10), pw3); \
    VRD(7); SBAR(); GAPA(C1=__builtin_amdgcn_mfma_f32_32x32x16_bf16(kf[7],qr[3],C1,0,0,0),   P1[14],P1[15],0.f,0.f,       pw3[2]=PKW(P1,12),pw3[3]=PKW(P1,14), pw3); \
    l_reg+=sacc; \
    if(GK){DMA_K((t)+3,sl_cur);} if(GV){DMA_V((t)+1,sl_next);} \
    CMASK(C0,C1,t); \
    if constexpr (!NOMAX) { float a=MX3(C0[0],C0[1],C1[0]),b=MX3(C0[2],C0[3],C1[1]); a=MX3(a,C1[2],C1[3]); \
      _Pragma("unroll") for(int r=4;r<16;r+=4){a=MX3(a,C0[r],C0[r+1]);b=MX3(b,C0[r+2],C0[r+3]);a=MX3(a,C1[r],C1[r+1]);b=MX3(b,C1[r+2],C1[r+3]);} \
      float rm=__builtin_fmaxf(a,b); { auto rr=__builtin_amdgcn_permlane32_swap(__float_as_uint(rm),__float_as_uint(rm),false,false); rm=__builtin_fmaxf(__uint_as_float(rr[0]),__uint_as_float(rr[1])); } \
      resc=false; \
      if(__builtin_expect(__any(rm>(float)THRL),0)){ const float dl=__builtin_fmaxf(rm,0.f); mhat+=dl; \
        _Pragma("unroll") for(int r=0;r<16;++r){C0[r]-=dl;C1[r]-=dl;} \
        _Pragma("unroll") for(int r=0;r<16;++r)negm[r]=-mhat; asm volatile("":"+v"(negm)); \
        const float f=__builtin_amdgcn_exp2f(-dl); l_reg*=f; if(hi==0)wsf[r32]=f; resc=true; } } \
    SBAR(); \
    GAPB(o[0]=__builtin_amdgcn_mfma_f32_32x32x16_bf16(PAF(0),VFR(0),o[0],0,0,0), C0,0); \
    GAPB(o[1]=__builtin_amdgcn_mfma_f32_32x32x16_bf16(PAF(0),VFR(4),o[1],0,0,0), C0,4); \
    KRD(GL,0); GAPB(o[0]=__builtin_amdgcn_mfma_f32_32x32x16_bf16(PAF(1),VFR(1),o[0],0,0,0), C0,8); \
    KRD(GL,1); GAPB(o[1]=__builtin_amdgcn_mfma_f32_32x32x16_bf16(PAF(1),VFR(5),o[1],0,0,0), C0,12); \
    KRD(GL,2); GAPB(o[0]=__builtin_amdgcn_mfma_f32_32x32x16_bf16(PAF(2),VFR(2),o[0],0,0,0), C1,0); \
    KRD(GL,3); GAPB(o[1]=__builtin_amdgcn_mfma_f32_32x32x16_bf16(PAF(2),VFR(6),o[1],0,0,0), C1,4); \
    GAPB(o[0]=__builtin_amdgcn_mfma_f32_32x32x16_bf16(PAF(3),VFR(3),o[0],0,0,0), C1,8); \
    GAPB(o[1]=__builtin_amdgcn_mfma_f32_32x32x16_bf16(PAF(3),VFR(7),o[1],0,0,0), C1,12); \
    }while(0)
  int t=1;
  #undef CMASK
  #define CMASK(P0,P1,t) do{}while(0)
  for(;t+5<NT;t+=2){
    STEP(pB0,pB1,pA0,pA1,t,true,true,true);     WAIT_BAR(2); RESC(); ROT();
    STEP(pA0,pA1,pB0,pB1,t+1,true,true,true);   WAIT_BAR(2); RESC(); ROT();
  }
  #undef CMASK
  #define CMASK(P0,P1,t) do{}while(0)
  #define ENDW(tt) do{ if((tt)+3<NT){WAIT_BAR(2);} else if((tt)+2<NT){WAIT_BAR(1);} else {WAIT_BAR(0);} }while(0)
  for(;t+1<NT;t+=2){
    STEP(pB0,pB1,pA0,pA1,t,(t+3<NT),(t+1<NT),(t+1<NT));       ENDW(t);   RESC(); ROT();
    STEP(pA0,pA1,pB0,pB1,t+1,(t+4<NT),(t+2<NT),(t+2<NT));     ENDW(t+1); RESC(); ROT();
  }
  STEP(pB0,pB1,pA0,pA1,NT-1,false,false,false); RESC();
  { float sacc=pB0[0]+pB0[1]; _Pragma("unroll") for(int r=2;r<16;++r)sacc+=pB0[r]; _Pragma("unroll") for(int r=0;r<16;++r)sacc+=pB1[r]; l_reg+=sacc;
    pw0=(u32x4){PKW(pB0,0),PKW(pB0,2),PKW(pB0,4),PKW(pB0,6)};pw1=(u32x4){PKW(pB0,8),PKW(pB0,10),PKW(pB0,12),PKW(pB0,14)};pw2=(u32x4){PKW(pB1,0),PKW(pB1,2),PKW(pB1,4),PKW(pB1,6)};pw3=(u32x4){PKW(pB1,8),PKW(pB1,10),PKW(pB1,12),PKW(pB1,14)};
    SBAR(); pv(o,vb0+sl_cur,PAF(0),PAF(1),PAF(2),PAF(3)); }
  #undef PKW
  #undef PAF
  #undef VFR
  #undef PIN
  #undef MX3
  #undef GAPA
  #undef GAPB
  #undef EX
  #undef VRD
  #undef KRD
  #undef STEP
  #undef ENDW
  {auto rr=__builtin_amdgcn_permlane32_swap(__float_as_uint(l_reg),__float_as_uint(l_reg),false,false);l_reg=__uint_as_float(rr[0])+__uint_as_float(rr[1]);}
  if(hi==0)wsf[32+r32]=l_reg;asm volatile("s_waitcnt lgkmcnt(0)":::"memory");
  float rli[16];
  #pragma unroll
  for(int r=0;r<16;++r)rli[r]=__builtin_amdgcn_rcpf(wsf[32+crow(r,hi)]);
  bf16*Ow=Ou+(long)(wid*QBLK)*DM;
  { bf16*stg=(bf16*)(shm+LDS_OST)+wid*2048;
    #pragma unroll
    for(int r=0;r<16;++r){const int orow=crow(r,hi);
      #pragma unroll
      for(int d0=0;d0<2;++d0)stg[orow*64+d0*32+r32]=__float2bfloat16(o[d0][r]*rli[r]);}
    asm volatile("s_waitcnt lgkmcnt(0)":::"memory");
    #pragma unroll
    for(int i=0;i<4;++i){const int row=i*8+(lane>>3),ch=lane&7; const u32x4 v=*(const u32x4*)(stg+row*64+ch*8); ATTN_STORE16(Ow+(long)row*DM+ch*8,v);} }
  asm volatile("s_waitcnt lgkmcnt(0)\n\ts_barrier":::"memory");
  #undef DMA_K
  #undef DMA_V
  #undef CMASK
  #undef START
  #undef RESC
  #undef ROT
}
constexpr int ATTN_LDS_BYTES=LDS_BYTES;
#undef SBAR
#undef WAIT_BAR
}
#define GAS __attribute__((address_space(1)))
#define LAS __attribute__((address_space(3)))
typedef unsigned short bf16;
typedef unsigned v4u __attribute__((ext_vector_type(4)));
typedef unsigned v2u __attribute__((ext_vector_type(2)));
typedef float f32x4 __attribute__((ext_vector_type(4)));
typedef short bf16x8 __attribute__((ext_vector_type(8)));
#define LDS_WAIT() asm volatile("s_waitcnt lgkmcnt(0)" ::: "memory")
__device__ __forceinline__ unsigned f2bf(float f) { unsigned u = __builtin_bit_cast(unsigned, f); return (u + 0x7fffu + ((u >> 16) & 1u)) >> 16; }
__device__ __forceinline__ unsigned pk2(float lo, float hi) { return f2bf(lo) | (f2bf(hi) << 16); }
__device__ __forceinline__ float bflo(unsigned w) { return __builtin_bit_cast(float, w << 16); }
__device__ __forceinline__ float bfhi(unsigned w) { return __builtin_bit_cast(float, w & 0xffff0000u); }

constexpr int NWAVES = 8, NTHR = 512;
constexpr int M_TOK = 32768, M_P = 16384, DMODEL = 1024, NQKV = 1536, FF = 2816, FF2 = 5632, SGI = 2048, SGI2 = 4096;
constexpr float EPS = 1e-6f;
constexpr size_t MiB = 1u << 20;
constexpr size_t WS_CTL = 0, CTL_BYTES = 1 * MiB;
constexpr size_t WS_WQKV = 1 * MiB, WS_WO = 4 * MiB, WS_WUP0 = 6 * MiB, WS_WDN0 = 17 * MiB, WS_WIN = 23 * MiB, WS_WOUT = 31 * MiB, WS_WUP1 = 35 * MiB, WS_WDN1 = 46 * MiB;
constexpr size_t WS_WS = 51 * MiB + 512 * 1024, WS_XN = 52 * MiB, WS_BIG = 116 * MiB, WS_END = 256 * MiB;
constexpr int LDS_BYTES = 163840;
constexpr size_t WS_BARW = 768 * 1024;
constexpr int LDSCTL_OFF = 131072, MISC_OFF = LDSCTL_OFF + 320;

__device__ __forceinline__ float wave_sum(float v) {
#pragma unroll
    for (int o = 1; o < 64; o <<= 1) v += __shfl_xor(v, o);
    return v;
}
__device__ __forceinline__ void p0_transpose_item(const float* W, const float* gain, int K, int N, bf16* WT, LAS float* scr, int item, int lane, bool ffn_up = false, bool qkv = false) {
    const int nblk = N / 32, kb = item / nblk, nb = item % nblk, k0 = 64 * kb, n0 = 32 * nb;
    int nd0 = n0; if (qkv && n0 < 1280) { const int head = n0 >> 6, bj = (n0 >> 5) & 1; nd0 = 256 * (head >> 2) + 128 * bj + 32 * (head & 3); }
    if (ffn_up) { const int x = n0 < FF ? n0 : n0 - FF; nd0 = 256 * (x / 128) + (x % 128) + (n0 < FF ? 0 : 128); }
    { float wv[32];
#pragma unroll
      for (int i = 0; i < 32; ++i) wv[i] = W[(size_t)(k0 + 2 * i + (lane >> 5)) * N + n0 + (lane & 31)];
      if (gain) {
#pragma unroll
          for (int i = 0; i < 32; ++i) wv[i] *= gain[k0 + 2 * i + (lane >> 5)]; }
#pragma unroll
      for (int i = 0; i < 32; ++i) scr[(2 * i + (lane >> 5)) * 33 + (lane & 31)] = wv[i]; }
    LDS_WAIT(); asm volatile("" ::: "memory");
    const int c = lane & 7;
#pragma unroll
    for (int j = 0; j < 4; ++j) { const int n = (lane >> 3) + 8 * j; const LAS float* s = scr + (8 * c) * 33 + n;
        v4u o; o.x = pk2(s[0 * 33], s[1 * 33]); o.y = pk2(s[2 * 33], s[3 * 33]); o.z = pk2(s[4 * 33], s[5 * 33]); o.w = pk2(s[6 * 33], s[7 * 33]);
        *(v4u*)(WT + (size_t)(nd0 + n) * K + k0 + 8 * c) = o; }
    LDS_WAIT(); asm volatile("" ::: "memory");
}

#define XB_TMO      128
#define XB_XCNT(j)  (256  + 64 * (j))
#define XB_XSUB(j)  (1280 + 64 * (j))
#define XB_XGEN(j)  (2304 + 64 * (j))
#define XB_TOP      3328
#define XB_TOPGEN   3392
#define XCD_BAR_WORDS 3456
#define XB_SPIN_CAP (1u << 18)

__device__ __forceinline__ unsigned xb_ld(unsigned* p)              { return __hip_atomic_load(p, __ATOMIC_RELAXED, __HIP_MEMORY_SCOPE_AGENT); }
__device__ __forceinline__ unsigned xb_add(unsigned* p, unsigned v) { return __hip_atomic_fetch_add(p, v, __ATOMIC_RELAXED, __HIP_MEMORY_SCOPE_AGENT); }
__device__ __forceinline__ unsigned xb_xcc_id() { return (unsigned)__builtin_amdgcn_s_getreg((3 << 11) | 20) & 0xFu; }
#define XB_SPIN(cond, bar) do { unsigned _sp = 0; while (cond) { __builtin_amdgcn_s_sleep(1); \
    if ((++_sp & 255u) == 0u) { if (xb_ld(&(bar)[XB_TMO])) break; if (_sp > XB_SPIN_CAP) { atomicAdd(&(bar)[XB_TMO], 1u); break; } } } } while (0)

struct XcdBarrier {
    unsigned* bar; unsigned x;
    volatile LAS unsigned* st;
};

__device__ __forceinline__ XcdBarrier xcd_barrier_post(unsigned* bar, volatile LAS unsigned* st) {
    XcdBarrier b; b.bar = bar; b.x = xb_xcc_id(); b.st = st;
    if (threadIdx.x == 0) (void)xb_add(&bar[XB_XCNT(b.x)], 1u);
    return b;
}
__device__ __forceinline__ void xcd_barrier_complete(unsigned* bar, unsigned x, unsigned& nloc, unsigned& nx) {
    const unsigned G = gridDim.x * gridDim.y * gridDim.z;
    unsigned sum, cnt, mine, sp = 0u;
    for (;;) {
        sum = 0u; cnt = 0u; mine = 0u;
#pragma unroll
        for (unsigned j = 0; j < 16; ++j) { const unsigned c = xb_ld(&bar[XB_XCNT(j)]); sum += c; cnt += (c > 0u) ? 1u : 0u; mine = (j == x) ? c : mine; }
        if (sum == G) break;
        __builtin_amdgcn_s_sleep(1);
        if ((++sp & 255u) == 0u) { if (xb_ld(&bar[XB_TMO])) break; if (sp > XB_SPIN_CAP) { atomicAdd(&bar[XB_TMO], 1u); break; } }
    }
    nloc = mine > 0u ? mine : 1u; nx = cnt > 0u ? cnt : 1u;
}

__device__ __forceinline__ void xcd_barrier(const XcdBarrier& b) {
    asm volatile("s_waitcnt vmcnt(0)" ::: "memory");
    __syncthreads();
    if (threadIdx.x == 0) {
        unsigned* bar = b.bar; unsigned bx_ = b.x; asm volatile("" : "+s"(bar), "+s"(bx_));
        __builtin_amdgcn_s_waitcnt(0);
        unsigned nloc = b.st[0], nx = b.st[1];
        if (nloc == 0u) { xcd_barrier_complete(bar, bx_, nloc, nx); b.st[0] = nloc; b.st[1] = nx; }
        const unsigned old = xb_add(&bar[XB_XSUB(bx_)], 1u);
        const unsigned gen = old / nloc;
        if (old + 1u == (gen + 1u) * nloc) {
            __builtin_amdgcn_fence(__ATOMIC_RELEASE, "agent");
            asm volatile("s_waitcnt vmcnt(0)" ::: "memory");
            const unsigned og = xb_add(&bar[XB_TOP], 1u);
            const unsigned tg = og / nx;
            if (og + 1u == (tg + 1u) * nx) xb_add(&bar[XB_TOPGEN], 1u);
            else XB_SPIN(xb_ld(&bar[XB_TOPGEN]) == tg, bar);
            __builtin_amdgcn_fence(__ATOMIC_ACQUIRE, "agent");
            xb_add(&bar[XB_XGEN(bx_)], 1u);
            asm volatile("s_waitcnt vmcnt(0)" ::: "memory");
        } else {
            XB_SPIN(xb_ld(&bar[XB_XGEN(bx_)]) == gen, bar);
            __builtin_amdgcn_fence(__ATOMIC_ACQUIRE, "agent");
            asm volatile("s_waitcnt vmcnt(0)" ::: "memory");
        }
    }
    __syncthreads();
}

struct Args { const float* in[17]; float* out; unsigned char* ws; };

__device__ __forceinline__ void p0_prologue(const Args& a, LAS unsigned char* lds, int gw, int NGW, int wave, int lane) {
    unsigned char* ws = a.ws;
    LAS float* scr = (LAS float*)(lds + wave * 16384);
    constexpr int I_QKV = 16 * 48, I_O = 16 * 32, I_UP = 16 * 176, I_DN = 44 * 32, I_IN = 16 * 128, I_OUT = 32 * 32;
    constexpr int NITEMS0 = I_QKV + I_O + I_UP + I_DN, NITEMS1 = I_UP + I_DN + I_IN + I_OUT;
    for (int it = gw; it < NITEMS0; it += NGW) {
        int r = it;
        if (r < I_QKV) { p0_transpose_item(a.in[4], a.in[2], 1024, NQKV, (bf16*)(ws + WS_WQKV), scr, r, lane, false, true); continue; } r -= I_QKV;
        if (r < I_O)   { p0_transpose_item(a.in[7], nullptr, 1024, 1024, (bf16*)(ws + WS_WO), scr, r, lane); continue; } r -= I_O;
        if (r < I_UP)  { p0_transpose_item(a.in[13], a.in[3], 1024, FF2, (bf16*)(ws + WS_WUP0), scr, r, lane, true); continue; } r -= I_UP;
        p0_transpose_item(a.in[16], nullptr, FF, 1024, (bf16*)(ws + WS_WDN0), scr, r, lane);
    }
    float* stat0 = (float*)(ws + WS_CTL);
    bf16* XN = (bf16*)(ws + WS_XN);
    for (int m0 = gw * 4; m0 < M_TOK; m0 += NGW * 4) {
        f32x4 v[4][4];
#pragma unroll
        for (int q = 0; q < 4; ++q) { const int m = m0 + q; const float* xrow = (m < M_P) ? a.in[0] + (size_t)m * 1024 : a.in[1] + (size_t)(m - M_P) * 1024;
            const f32x4* xr = (const f32x4*)xrow + lane;
#pragma unroll
            for (int j = 0; j < 4; ++j) v[q][j] = xr[64 * j]; }
#pragma unroll
        for (int q = 0; q < 4; ++q) { const int m = m0 + q; float s = 0.f;
#pragma unroll
            for (int j = 0; j < 4; ++j) s += (v[q][j].x * v[q][j].x + v[q][j].y * v[q][j].y) + (v[q][j].z * v[q][j].z + v[q][j].w * v[q][j].w);
            s = wave_sum(s);
            v2u* o8 = (v2u*)(XN + (size_t)m * 1024) + lane;
#pragma unroll
            for (int j = 0; j < 4; ++j) { v2u w; w.x = pk2(v[q][j].x, v[q][j].y); w.y = pk2(v[q][j].z, v[q][j].w); o8[64 * j] = w; }
            if (lane == 0) stat0[m] = s; }
    }
}

__device__ __forceinline__ void p0_layer1_weights(const Args& a, LAS unsigned char* lds, int part, int w, int nw, int wave, int lane) {
    asm volatile("" : "+v"(lane));
    asm volatile("" : "+s"(nw), "+s"(w));
    unsigned char* ws = a.ws;
    LAS float* scr = (LAS float*)(lds + wave * 16384);
    constexpr int I_UP = 16 * 176, I_DN = 44 * 32, I_IN = 16 * 128, I_OUT = 32 * 32, NITEMS1 = I_UP + I_DN + I_IN + I_OUT, HALFI = NITEMS1 / 2;
#pragma unroll 1
    for (int it = part * HALFI + w; it < (part + 1) * HALFI; it += nw) {
        int r = it;
        if (r < I_UP)  { p0_transpose_item(a.in[13] + (size_t)1024 * FF2, a.in[3] + 1024, 1024, FF2, (bf16*)(ws + WS_WUP1), scr, r, lane, true); continue; } r -= I_UP;
        if (r < I_DN)  { p0_transpose_item(a.in[16] + (size_t)FF * 1024, nullptr, FF, 1024, (bf16*)(ws + WS_WDN1), scr, r, lane); continue; } r -= I_DN;
        if (r < I_IN)  { p0_transpose_item(a.in[8], a.in[2] + 1024, 1024, SGI2, (bf16*)(ws + WS_WIN), scr, r, lane); continue; } r -= I_IN;
        p0_transpose_item(a.in[12], nullptr, SGI, 1024, (bf16*)(ws + WS_WOUT), scr, r, lane);
    }
    if (part == 0) { const float* s = a.in[10]; unsigned* d = (unsigned*)(ws + WS_WS);
      for (int i = w * 64 + lane; i < 8 * 128 * 128 / 2; i += nw * 64) d[i] = pk2(s[2 * i], s[2 * i + 1]); }
}

__device__ __forceinline__ void rope_phase(bf16* QKV, const float* qg, const float* kg, int gw, int NGW, int lane) {
    const int half = lane >> 5, j = lane & 31, i = j & 15, da = (j >> 4) * 32 + i, db = da + 16;
    const float inv_freq = __builtin_amdgcn_exp2f(-(float)i * 0.830482024f);
    const float qga = qg[da], qgb = qg[db], kga = kg[da], kgb = kg[db];
    for (int r = gw; r < M_TOK; r += NGW) {
        const int t = (r < M_P) ? (r & 8191) : (r & 2047);
        const float pos = (float)((j < 16) ? (t >> 6) : (t & 63));
        float rev = pos * inv_freq * 0.15915494309189535f; rev -= floorf(rev);
        const float sn = __builtin_amdgcn_sinf(rev), cs = __builtin_amdgcn_cosf(rev);
        bf16* row = QKV + (size_t)r * NQKV;
#pragma unroll
        for (int it = 0; it < 10; ++it) {
            bf16* p = row + (2 * it + half) * 64;
            float x = __builtin_bit_cast(float, (unsigned)p[da] << 16), y = __builtin_bit_cast(float, (unsigned)p[db] << 16);
            float ss = x * x + y * y;
#pragma unroll
            for (int o = 1; o < 32; o <<= 1) ss += __shfl_xor(ss, o);
            const float rn = __builtin_amdgcn_rsqf(ss * (1.0f / 64.0f) + EPS);
            const bool isq = it < 8;
            x *= rn * (isq ? qga : kga); y *= rn * (isq ? qgb : kgb);
            float ox = x * cs - y * sn, oy = y * cs + x * sn;
            if (isq) { ox *= attn_body::C2; oy *= attn_body::C2; }
            p[da] = (bf16)f2bf(ox); p[db] = (bf16)f2bf(oy);
        }
    }
}

__device__ __forceinline__ void unpack8(const v4u w, float (&f)[8]) { f[0] = bflo(w.x); f[1] = bfhi(w.x); f[2] = bflo(w.y); f[3] = bfhi(w.y); f[4] = bflo(w.z); f[5] = bfhi(w.z); f[6] = bflo(w.w); f[7] = bfhi(w.w); }
__device__ __forceinline__ void ffn_fixup(const bf16* HALO, bf16* ACT, int pm, int grow_h0, const float* cw, const float* cb) {
    int tid = threadIdx.x; asm volatile("" : "+v"(tid));
    constexpr int NCG = FF / 8;
#pragma unroll 1
    for (int it = tid; it < 8 * NCG; it += NTHR) {
        const int cgi = it % NCG, br = it / NCG, blk = pm * 4 + (br >> 1); const bool bot = (br & 1) != 0;
        const int a0 = cgi * 8, ng = 256 * (a0 >> 7) + (a0 & 127);
        const int lrow = blk * 64 + (bot ? 63 : 0), grow = grow_h0 + lrow, L = (grow < M_P) ? 8192 : 2048;
        const bool zp = !bot && ((grow & (L - 1)) == 0), zn = bot && (((grow + 1) & (L - 1)) == 0);
        const bf16* hb = HALO + (size_t)blk * 4 * FF2 + ng;
        const bf16* pp = bot ? hb + 2 * FF2 : hb - FF2; const bf16* pc = bot ? hb + 3 * FF2 : hb; const bf16* pn_ = bot ? hb + 4 * FF2 : hb + FF2;
        float pg[8], pu[8], cg_[8], cu[8], ng_[8], nu[8];
        if (zp) {
#pragma unroll
            for (int e = 0; e < 8; ++e) { pg[e] = 0.f; pu[e] = 0.f; } }
        else { unpack8(*(const v4u*)pp, pg); unpack8(*(const v4u*)(pp + 128), pu); }
        unpack8(*(const v4u*)pc, cg_); unpack8(*(const v4u*)(pc + 128), cu);
        if (zn) {
#pragma unroll
            for (int e = 0; e < 8; ++e) { ng_[e] = 0.f; nu[e] = 0.f; } }
        else { unpack8(*(const v4u*)pn_, ng_); unpack8(*(const v4u*)(pn_ + 128), nu); }
        float o[8];
#pragma unroll
        for (int h = 0; h < 2; ++h) {
            f32x4 wg[3], wu[3];
#pragma unroll
            for (int k = 0; k < 3; ++k) { wg[k] = *(const f32x4*)(cw + k * FF2 + a0 + 4 * h); wu[k] = *(const f32x4*)(cw + k * FF2 + FF + a0 + 4 * h); }
            const f32x4 bg = *(const f32x4*)(cb + a0 + 4 * h), bu = *(const f32x4*)(cb + FF + a0 + 4 * h);
#pragma unroll
            for (int j = 0; j < 4; ++j) { const int e = 4 * h + j;
                const float g = pg[e] * wg[0][j] + cg_[e] * wg[1][j] + ng_[e] * wg[2][j] + bg[j];
                const float u = pu[e] * wu[0][j] + cu[e] * wu[1][j] + nu[e] * wu[2][j] + bu[j];
                o[e] = g * __builtin_amdgcn_rcpf(1.0f + __builtin_amdgcn_exp2f(-1.4426950408889634f * g)) * u; }
        }
        v4u w; w.x = pk2(o[0], o[1]); w.y = pk2(o[2], o[3]); w.z = pk2(o[4], o[5]); w.w = pk2(o[6], o[7]);
        *(v4u*)(ACT + (size_t)lrow * FF + a0) = w;
    }
}

constexpr int SG_PITCH = 272;
__device__ __forceinline__ void sgu_prefetch_v(const bf16* Z, int rloc0, int grow0, int g, const float* vgain, const float* vstat, int tid, v4u (&v)[8], float (&st)[8], f32x4 (&vg)[2]) {
    const int db = tid & 31, qb = tid >> 5, d0 = 8 * db, q0 = 8 * qb;
#pragma unroll
    for (int i = 0; i < 8; ++i) { v[i] = *(const v4u*)(Z + (size_t)(rloc0 + q0 + i) * SGI2 + SGI + 256 * g + d0); st[i] = vstat[grow0 + q0 + i]; }
    vg[0] = *(const f32x4*)(vgain + 256 * g + d0); vg[1] = *(const f32x4*)(vgain + 256 * g + d0 + 4);
}
__device__ __forceinline__ void sgu_prefetch_u(const bf16* Z, int rloc0, int g, int tid, v4u (&uw)[8]) {
#pragma unroll
    for (int i = 0; i < 8; ++i) uw[i] = *(const v4u*)(Z + (size_t)(rloc0 + (tid >> 5) + 16 * i) * SGI2 + 256 * g + 8 * (tid & 31));
}
__device__ __forceinline__ void sgu_phase(LAS unsigned char* lds, bf16* Z, int r0, const bf16* wsb, const float* bs, const float* vgain, const float* vstat, int vcu, int G) {
    int tid_ = threadIdx.x; asm volatile("" : "+v"(tid_));
    const int tid = tid_, lane = tid & 63, wid = __builtin_amdgcn_readfirstlane(tid >> 6), fr = lane & 15, fq = lane >> 4;
    LAS unsigned char* ldsA = lds + 256 * SG_PITCH;
    v4u v[8]; float st[8]; v4u uw[8]; f32x4 vg[2];
    int u = vcu, g_staged = -1;
    constexpr int SP = 528;
    if (u < 1024) sgu_prefetch_v(Z, (u >> 3) * 128, r0 + (u >> 3) * 128, u & 7, vgain, vstat, tid, v, st, vg);
#pragma unroll 1
    for (; u < 1024; u += G) {
        const int g = u & 7, rloc0 = (u >> 3) * 128;
        sgu_prefetch_u(Z, rloc0, g, tid, uw);
        __syncthreads();
        {
            const int db = tid & 31, qb = tid >> 5, d0 = 8 * db;
            float rs[8];
#pragma unroll
            for (int i = 0; i < 8; ++i) rs[i] = __builtin_amdgcn_rsqf(st[i] * (1.0f / 2048.0f) + EPS);
#pragma unroll
            for (int kh = 0; kh < 2; ++kh) {
                float val[8][4];
#pragma unroll
                for (int i = 0; i < 8; ++i) { const unsigned w0 = kh ? v[i].z : v[i].x, w1 = kh ? v[i].w : v[i].y;
                    val[i][0] = bflo(w0) * rs[i] * vg[kh][0]; val[i][1] = bfhi(w0) * rs[i] * vg[kh][1]; val[i][2] = bflo(w1) * rs[i] * vg[kh][2]; val[i][3] = bfhi(w1) * rs[i] * vg[kh][3]; }
#pragma unroll
                for (int k = 0; k < 4; ++k) {
                    v4u o; o.x = pg8::cvt_pk_bf16(val[0][k], val[1][k]); o.y = pg8::cvt_pk_bf16(val[2][k], val[3][k]); o.z = pg8::cvt_pk_bf16(val[4][k], val[5][k]); o.w = pg8::cvt_pk_bf16(val[6][k], val[7][k]);
                    const int d = d0 + 4 * kh + k;
                    *(LAS v4u*)(lds + d * SG_PITCH + ((qb ^ (db & 15)) << 4)) = o;
                }
            }
            if (g != g_staged) { g_staged = g;
#pragma unroll
                for (int i = 0; i < 4; ++i) { const int e = tid + NTHR * i, p = e >> 4, ch = e & 15; *(LAS v4u*)(ldsA + p * SG_PITCH + (ch << 4)) = *(const v4u*)(wsb + (size_t)g * 16384 + (size_t)e * 8); } }
        }
        __syncthreads();
        { const int un = u + G; if (un < 1024) sgu_prefetch_v(Z, (un >> 3) * 128, r0 + (un >> 3) * 128, un & 7, vgain, vstat, tid, v, st, vg); }
        f32x4 acc[8][2];
#pragma unroll
        for (int mt = 0; mt < 8; ++mt)
#pragma unroll
            for (int nt = 0; nt < 2; ++nt) acc[mt][nt] = (f32x4){0.f, 0.f, 0.f, 0.f};
#pragma unroll
        for (int ks = 0; ks < 4; ++ks) {
            bf16x8 bfr[2];
#pragma unroll
            for (int nt = 0; nt < 2; ++nt) { const int d = 32 * wid + 16 * nt + fr; bfr[nt] = *(const LAS bf16x8*)(lds + d * SG_PITCH + ((((4 * ks + fq) ^ ((d >> 3) & 15))) << 4)); }
#pragma unroll
            for (int mt = 0; mt < 8; ++mt) {
                const bf16x8 afr = *(const LAS bf16x8*)(ldsA + (16 * mt + fr) * SG_PITCH + ((4 * ks + fq) << 4));
#pragma unroll
                for (int nt = 0; nt < 2; ++nt) acc[mt][nt] = __builtin_amdgcn_mfma_f32_16x16x32_bf16(bfr[nt], afr, acc[mt][nt], 0, 0, 0);
            }
        }
        __syncthreads();
#pragma unroll
        for (int mt = 0; mt < 8; ++mt) {
            const int p = 16 * mt + fr; const float b1 = bs[g * 128 + p];
#pragma unroll
            for (int nt = 0; nt < 2; ++nt) { const f32x4 sv = acc[mt][nt]; v2u o; o.x = pg8::cvt_pk_bf16(sv[0] + b1, sv[1] + b1); o.y = pg8::cvt_pk_bf16(sv[2] + b1, sv[3] + b1);
                *(LAS v2u*)(lds + p * SP + (32 * wid + 16 * nt + 4 * fq) * 2) = o; }
        }
        __syncthreads();
#pragma unroll
        for (int i = 0; i < 8; ++i) {
            const int row = (tid >> 5) + 16 * i; const v4u sw = *(const LAS v4u*)(lds + row * SP + (tid & 31) * 16); const v4u u4 = uw[i];
            v4u o; o.x = pg8::cvt_pk_bf16(bflo(u4.x) * bflo(sw.x), bfhi(u4.x) * bfhi(sw.x)); o.y = pg8::cvt_pk_bf16(bflo(u4.y) * bflo(sw.y), bfhi(u4.y) * bfhi(sw.y));
            o.z = pg8::cvt_pk_bf16(bflo(u4.z) * bflo(sw.z), bfhi(u4.z) * bfhi(sw.z)); o.w = pg8::cvt_pk_bf16(bflo(u4.w) * bflo(sw.w), bfhi(u4.w) * bfhi(sw.w));
            *(v4u*)(Z + (size_t)(rloc0 + row) * SGI2 + 256 * g + 8 * (tid & 31)) = o;
        }
    }
}

__global__ void __launch_bounds__(NTHR, 2) mk_fwd(Args a) {
    extern __shared__ __attribute__((aligned(16))) unsigned char lds_raw[];
    cg::grid_group grid = cg::this_grid();
    LAS unsigned char* lds = (LAS unsigned char*)lds_raw;
    const int tid = threadIdx.x, lane = tid & 63, wave = __builtin_amdgcn_readfirstlane(tid >> 6);
    const int G = gridDim.x, bx = blockIdx.x, vcu = (G % 8 == 0) ? (bx % 8) * (G / 8) + bx / 8 : bx;
    const int gw = vcu * NWAVES + wave, NGW = G * NWAVES;
    unsigned char* ws = a.ws;
    float* stat0 = (float*)(ws + WS_CTL); float* stat1 = stat0 + M_TOK; float* stat2 = stat1 + M_TOK; float* stat3 = stat2 + M_TOK; float* stat4 = stat3 + M_TOK;
    bf16* XN = (bf16*)(ws + WS_XN); bf16* BIG = (bf16*)(ws + WS_BIG);
    float* out = a.out;
    for (int u = tid; u < (LDS_BYTES - LDSCTL_OFF) / 4; u += NTHR) ((LAS unsigned*)(lds + LDSCTL_OFF))[u] = 0u;
    __syncthreads();
    XcdBarrier bar = xcd_barrier_post((unsigned*)(ws + WS_BARW), (volatile LAS unsigned*)(lds + MISC_OFF) + 8);
#define GSYNC() xcd_barrier(bar)

    p0_prologue(a, lds, gw, NGW, wave, lane);
    if (a.out == nullptr) grid.sync();
    GSYNC();
    { pg8::Gemm g{XN, (const bf16*)(ws + WS_WQKV), M_TOK, NQKV, 1024, 1024, 1024}; pg8::StaticOrder S; S.init(M_TOK, NQKV, G, bx);
      pg8::EpiQKV E{BIG, stat0, a.in[5], a.in[6]};
      pg8::gemm_phase<pg8::EpiQKV, pg8::StaticOrder, true, true>(lds, g, S, E); }
    GSYNC();
    { const attn_body::bf16* QKV = (const attn_body::bf16*)BIG;
      float mq = __builtin_fabsf(a.in[5][lane]), mk = __builtin_fabsf(a.in[6][lane]);
#pragma unroll
      for (int o = 1; o < 64; o <<= 1) { mq = __builtin_fmaxf(mq, __shfl_xor(mq, o)); mk = __builtin_fmaxf(mk, __shfl_xor(mk, o)); }
      const int nomax = __builtin_amdgcn_readfirstlane((mq * mk < 4.0f) ? 1 : 0);
#define ATT_LOOPS(NM) \
      for (int k = vcu * 4; k < 1024; k += G * 4) \
          for (int i = 0; i < 4; ++i) { const int u = k + i, bh = u >> 5, qb = u & 31, b = bh >> 4, h = bh & 15; const size_t row0 = (size_t)b * 8192; \
              const attn_body::bf16* Qu = QKV + (row0 + qb * 256) * NQKV + h * 64; const attn_body::bf16* Kh = QKV + row0 * NQKV + 1024 + (h >> 2) * 64; \
              attn_body::attn_unit<8, NM>(Qu, Kh, Kh + 256, (attn_body::bf16*)Qu, 128, (char*)lds_raw); } \
      for (int k = vcu * 4; k < 1024; k += G * 4) \
          for (int i = 0; i < 4; ++i) { const int u = k + i, bh = u >> 3, qb = u & 7, b = bh >> 4, h = bh & 15; const size_t row0 = (size_t)M_P + (size_t)b * 2048; \
              const attn_body::bf16* Qu = QKV + (row0 + qb * 256) * NQKV + h * 64; const attn_body::bf16* Kh = QKV + row0 * NQKV + 1024 + (h >> 2) * 64; \
              attn_body::attn_unit<8, NM>(Qu, Kh, Kh + 256, (attn_body::bf16*)Qu, 32, (char*)lds_raw); }
      if (nomax) { ATT_LOOPS(true) } else { ATT_LOOPS(false) }
#undef ATT_LOOPS
    }
    GSYNC();
    { pg8::Gemm g{BIG, (const bf16*)(ws + WS_WO), M_TOK, 1024, 1024, NQKV, 1024}; pg8::StaticOrder S; S.init(M_TOK, 1024, G, bx);
      pg8::EpiRes E{nullptr, nullptr, 0x7fffffff, nullptr, XN, stat1, 0, XN};
      pg8::gemm_phase<pg8::EpiRes, pg8::StaticOrder, true, true>(lds, g, S, E); }
    GSYNC();
#pragma unroll 1
    for (int layer = 0; layer < 2; ++layer) {
        if (layer == 1) {
#pragma unroll 1
            for (int hf = 0; hf < 2; ++hf) {
                const int r0 = hf * 16384;
                { pg8::Gemm g{XN + (size_t)r0 * 1024, (const bf16*)(ws + WS_WIN), 16384, SGI2, 1024, 1024, 1024}; pg8::StaticOrder S; S.init(16384, SGI2, G, bx);
                  pg8::EpiBf16S<2> E{BIG, SGI2, stat2, 1.0f / 1024.0f, r0, stat3, SGI};
                  pg8::gemm_phase<pg8::EpiBf16S<2>, pg8::StaticOrder, true, true>(lds, g, S, E); }
                GSYNC();
                sgu_phase(lds, BIG, r0, (const bf16*)(ws + WS_WS), a.in[11], a.in[9], stat3, vcu, G);
                GSYNC();
                { pg8::Gemm g{BIG, (const bf16*)(ws + WS_WOUT), 16384, 1024, SGI, SGI2, SGI}; pg8::StaticOrder S; S.init(16384, 1024, G, bx);
                  pg8::EpiRes E{nullptr, nullptr, 0x7fffffff, nullptr, XN, stat4, r0, XN};
                  pg8::gemm_phase<pg8::EpiRes, pg8::StaticOrder, true, true>(lds, g, S, E); }
                GSYNC();
            }
        }
        const bf16* Wup = (const bf16*)(ws + (layer ? WS_WUP1 : WS_WUP0)); const bf16* Wdn = (const bf16*)(ws + (layer ? WS_WDN1 : WS_WDN0));
        const float* st_in = layer ? stat4 : stat1;
        const float* cw = a.in[14] + (size_t)layer * 3 * FF2; const float* cb = a.in[15] + (size_t)layer * FF2;
        bf16* ACT = BIG; bf16* HALO = BIG + (size_t)16384 * FF;
#pragma unroll 1
        for (int hf = 0; hf < 2; ++hf) {
            const int r0 = hf * 16384;
            { pg8::Gemm g{XN + (size_t)r0 * 1024, Wup, 16384, FF2, 1024, 1024, 1024}; pg8::StaticOrder S; S.init(16384, FF2, G, bx);
              pg8::EpiConv E{ACT, HALO, st_in, r0, cw, cb};
              pg8::gemm_phase<pg8::EpiConv, pg8::StaticOrder, true, true>(lds, g, S, E); }
            if (layer == 0) {
                const bool spare = (G == 256) ? (bx >= 128) : true;
                if (spare) { const int nb = (G == 256) ? 128 : G, bi = (G == 256) ? bx - 128 : bx; p0_layer1_weights(a, lds, hf, bi * NWAVES + wave, nb * NWAVES, wave, lane); }
            }
            GSYNC();
            { pg8::Gemm g{ACT, Wdn, 16384, 1024, FF, FF, FF}; pg8::StaticOrder S; S.init(16384, 1024, G, bx);
              { pg8::Unit uu; for (int i = 0; S.next(i, uu); ++i) ffn_fixup(HALO, ACT, uu.pm, r0, cw, cb); }
              asm volatile("s_waitcnt vmcnt(0)" ::: "memory"); __syncthreads();
              if (layer == 0) { pg8::EpiRes E{nullptr, nullptr, 0x7fffffff, nullptr, XN, stat2, r0, XN};
                  pg8::gemm_phase<pg8::EpiRes, pg8::StaticOrder, true, true>(lds, g, S, E); }
              else { pg8::EpiResF E{nullptr, nullptr, 0x7fffffff, out, nullptr, nullptr, r0, XN};
                  pg8::gemm_phase<pg8::EpiResF, pg8::StaticOrder, true, true>(lds, g, S, E); } }
            if (!(layer == 1 && hf == 1)) GSYNC();
        }
    }
}

extern "C" void kernel_launch(void* const* d_in, const int* in_sizes, int n_in, void* d_out, int out_size, void* d_ws, size_t ws_size, hipStream_t stream) {
    static int grid = 0;
    if (grid == 0) {
        if (n_in != 17 || out_size != M_TOK * 1024 || ws_size < WS_END) { fprintf(stderr, "kernel_launch: unexpected shapes (n_in %d out %d ws %zu)\n", n_in, out_size, ws_size); grid = -1; return; }
        int dev = 0, cus = 0, per_cu = 0;
        if (hipGetDevice(&dev) != hipSuccess || hipDeviceGetAttribute(&cus, hipDeviceAttributeMultiprocessorCount, dev) != hipSuccess) { grid = -1; return; }
        if (hipFuncSetAttribute((const void*)mk_fwd, hipFuncAttributeMaxDynamicSharedMemorySize, LDS_BYTES) != hipSuccess) { fprintf(stderr, "kernel_launch: hipFuncSetAttribute failed\n"); grid = -1; return; }
        if (hipOccupancyMaxActiveBlocksPerMultiprocessor(&per_cu, (const void*)mk_fwd, NTHR, LDS_BYTES) != hipSuccess || per_cu < 1) { fprintf(stderr, "kernel_launch: occupancy query says %d\n", per_cu); per_cu = 1; }
        (void)hipGetLastError();
        grid = cus;
    }
    if (grid < 0) return;
    (void)hipMemsetAsync((char*)d_ws + WS_CTL, 0, CTL_BYTES, stream);
    Args a{};
    for (int i = 0; i < 17; ++i) a.in[i] = (const float*)d_in[i];
    a.out = (float*)d_out; a.ws = (unsigned char*)d_ws;
    void* args[] = {&a};
    hipError_t e = hipLaunchCooperativeKernel((const void*)mk_fwd, dim3(grid), dim3(NTHR), args, LDS_BYTES, stream);
    if (e != hipSuccess) fprintf(stderr, "kernel_launch: cooperative launch failed: %s (grid %d)\n", hipGetErrorString(e), grid);
}
```

```cpp
#include <hip/hip_runtime.h>
#include <hip/hip_cooperative_groups.h>
namespace cg = cooperative_groups;
#include <cstdio>
#include <cstdint>
namespace pg8 {
#define PG8_LAS __attribute__((address_space(3)))
typedef unsigned short bf16_t;
typedef short bf16x8 __attribute__((ext_vector_type(8)));
typedef float f32x4 __attribute__((ext_vector_type(4)));
typedef unsigned u32x4 __attribute__((ext_vector_type(4)));
constexpr int BM = 256, BK = 64, HALF = 128, HTB = HALF * BK * 2  , STAGE_BYTES = 8 * HTB, NXCD = 8, WGM = 8;

__host__ __device__ __forceinline__ int lds_byte(int r, int c) { const int st = (r >> 4) * 2 + (c >> 5), rr = r & 15, cc = c & 31, ob = rr * 64 + cc * 2; return st * 1024 + (ob ^ (((ob >> 9) & 1) << 5)); }
__host__ __device__ __forceinline__ void stage_rc(int b, int& R, int& C) { const int st = b / 1024, sb = b % 1024, swz = sb ^ (((sb >> 9) & 1) << 5); R = (st >> 1) * 16 + swz / 64; C = (st & 1) * 32 + (swz % 64) / 2; }
__host__ __device__ __forceinline__ int perm32(int rho) { const int n = rho >> 4, i = rho & 15; return 8 * (i >> 2) + 4 * n + (i & 3); }

struct Unit { int pm, pn; };
struct Gemm { const bf16_t* A; const bf16_t* Bt; int M, N, K, lda, ldb; };

struct StaticOrder {
    int nM, nN, nwg, G, c;
    __host__ __device__ __forceinline__ void init(int M, int N, int G_, int c_) { nM = M / BM; nN = N / BM; nwg = nM * nN; G = G_; c = c_; }
    __host__ __device__ __forceinline__ bool next(int i, Unit& u) const {
        const long L = (long)i * G + c; if (L >= nwg) return false;
        int wgid = (int)L; { const int q = nwg / NXCD, r = nwg % NXCD, xcd = wgid % NXCD, off = wgid / NXCD; wgid = (xcd < r ? xcd * (q + 1) : r * (q + 1) + (xcd - r) * q) + off; }
        const int nig = WGM * nN, gid = wgid / nig, fm = gid * WGM, gsz = (nM - fm) < WGM ? (nM - fm) : WGM;
        u.pm = fm + ((wgid % nig) % gsz); u.pn = (wgid % nig) / gsz; return true;
    }
    __device__ __forceinline__ void a_ready(const Unit&) const {}
    __device__ __forceinline__ void done(const Unit&) const {}
};

__device__ __forceinline__ unsigned cvt_pk_bf16(float lo, float hi) { unsigned r; asm volatile("v_cvt_pk_bf16_f32 %0, %1, %2" : "=v"(r) : "v"(lo), "v"(hi)); return r; }
typedef float f32x2 __attribute__((ext_vector_type(2)));
__device__ __forceinline__ float gelu_tanh(float x) { const float u = x * x * 0.044715f + 1.0f; const float e = __builtin_amdgcn_exp2f(-2.302208198f * x * u); return x * __builtin_amdgcn_rcpf(1.0f + e); }

template <int ACT> struct EpiBf16S {
    static constexpr bool PERM = true, AFTER_DRAIN = false, ROWPERM = false; static constexpr int NPARAM = 1;
    bf16_t* O; int ldc; const float* rstat; float rdim_inv; int row_off; float* vstat; int vcol0;
    __device__ __forceinline__ void stage_params(const Unit& u, PG8_LAS unsigned char* pbuf, int wr, int wc, int lane) const {
        asm volatile("" : "+v"(lane));
        if (lane < 32) { const float* gp = rstat + row_off + u.pm * BM + (lane >> 4) * HALF + wr * 64 + 4 * (lane & 15);
            __builtin_amdgcn_global_load_lds((const unsigned*)gp, (PG8_LAS unsigned*)pbuf, 16, 0, 0); }
    }
    __device__ __forceinline__ void operator()(const f32x4 (&acc)[2][2][4][2], const Unit& u, int wr, int wc, int fr, int fq, PG8_LAS unsigned char* pbuf) const {
        const int row0 = u.pm * BM + wr * 64 + fr, col0 = u.pn * BM + wc * 32 + 8 * fq;
        const bool dov = (vstat != nullptr) && (u.pn * BM >= vcol0);
        float ssv[2][4] = {{0.f, 0.f, 0.f, 0.f}, {0.f, 0.f, 0.f, 0.f}};
#pragma unroll
        for (int ai = 0; ai < 2; ++ai)
#pragma unroll
            for (int m = 0; m < 4; ++m) {
                const int r = row0 + ai * HALF + m * 16;
                const float sc = __builtin_amdgcn_rsqf(*(const PG8_LAS float*)(pbuf + (ai * 64 + m * 16 + fr) * 4) * rdim_inv + 1e-6f);
                bf16_t* rowp = O + (size_t)r * ldc + col0; float ss = 0.f;
#pragma unroll
                for (int bj = 0; bj < 2; ++bj) { f32x4 v0 = acc[ai][bj][m][0] * sc, v1 = acc[ai][bj][m][1] * sc;
                    if (ACT == 2) {
#pragma unroll
                        for (int j = 0; j < 4; ++j) { v0[j] = gelu_tanh(v0[j]); v1[j] = gelu_tanh(v1[j]); } }
                    if (dov) ss += (v0[0] * v0[0] + v0[1] * v0[1]) + (v0[2] * v0[2] + v0[3] * v0[3]) + (v1[0] * v1[0] + v1[1] * v1[1]) + (v1[2] * v1[2] + v1[3] * v1[3]);
                    u32x4 w; w.x = cvt_pk_bf16(v0[0], v0[1]); w.y = cvt_pk_bf16(v0[2], v0[3]); w.z = cvt_pk_bf16(v1[0], v1[1]); w.w = cvt_pk_bf16(v1[2], v1[3]);
                    *(u32x4*)(rowp + bj * HALF) = w; }
                if (dov) { ss += __shfl_xor(ss, 16); ss += __shfl_xor(ss, 32); ssv[ai][m] = ss; }
            }
        if (dov) {
#pragma unroll
            for (int ai = 0; ai < 2; ++ai) { const float v = (fq == 0) ? ssv[ai][0] : (fq == 1) ? ssv[ai][1] : (fq == 2) ? ssv[ai][2] : ssv[ai][3];
                atomicAdd(vstat + row_off + u.pm * BM + ai * HALF + wr * 64 + 16 * fq + fr, v); }
        }
    }
};

struct EpiRes {
    static constexpr int NPARAM = 0;
    static constexpr bool PERM = true, AFTER_DRAIN = false, ROWPERM = false;
    const float* base0; const float* base1; int split_row; float* out; bf16_t* xn; float* stat; int row_off; const bf16_t* bbase;
    __device__ __forceinline__ void operator()(const f32x4 (&acc)[2][2][4][2], const Unit& u, int wr, int wc, int fr, int fq, PG8_LAS unsigned char* pbuf) const {
        const int col0 = u.pn * BM + wc * 32 + 8 * fq;
        float ssv[2][4];
#pragma unroll
        for (int ai = 0; ai < 2; ++ai)
#pragma unroll
            for (int m = 0; m < 4; ++m) {
                const int r = row_off + u.pm * BM + ai * HALF + wr * 64 + m * 16 + fr;
                const float* b = (r < split_row) ? base0 + (size_t)r * 1024 : base1 + (size_t)(r - split_row) * 1024;
                float* o = out + (size_t)r * 1024; float ss = 0.f;
#pragma unroll
                for (int bj = 0; bj < 2; ++bj) { const int c = col0 + bj * HALF;
                    f32x4 b0, b1;
                    if (bbase) { const u32x4 w = *(const u32x4*)(bbase + (size_t)r * 1024 + c);
                        b0 = (f32x4){__builtin_bit_cast(float, w.x << 16), __builtin_bit_cast(float, w.x & 0xffff0000u), __builtin_bit_cast(float, w.y << 16), __builtin_bit_cast(float, w.y & 0xffff0000u)};
                        b1 = (f32x4){__builtin_bit_cast(float, w.z << 16), __builtin_bit_cast(float, w.z & 0xffff0000u), __builtin_bit_cast(float, w.w << 16), __builtin_bit_cast(float, w.w & 0xffff0000u)}; }
                    else { b0 = *(const f32x4*)(b + c); b1 = *(const f32x4*)(b + c + 4); }
                    const f32x4 x0 = b0 + acc[ai][bj][m][0], x1 = b1 + acc[ai][bj][m][1];
                    if (out) { *(f32x4*)(o + c) = x0; *(f32x4*)(o + c + 4) = x1; }
                    ss += (x0[0] * x0[0] + x0[1] * x0[1]) + (x0[2] * x0[2] + x0[3] * x0[3]) + (x1[0] * x1[0] + x1[1] * x1[1]) + (x1[2] * x1[2] + x1[3] * x1[3]);
                    if (xn) { u32x4 w; w.x = cvt_pk_bf16(x0[0], x0[1]); w.y = cvt_pk_bf16(x0[2], x0[3]); w.z = cvt_pk_bf16(x1[0], x1[1]); w.w = cvt_pk_bf16(x1[2], x1[3]); *(u32x4*)(xn + (size_t)r * 1024 + c) = w; } }
                ss += __shfl_xor(ss, 16); ss += __shfl_xor(ss, 32); ssv[ai][m] = ss;
                asm volatile("" ::: "memory");
            }
        if (stat) {
#pragma unroll
            for (int ai = 0; ai < 2; ++ai) { const float v = (fq == 0) ? ssv[ai][0] : (fq == 1) ? ssv[ai][1] : (fq == 2) ? ssv[ai][2] : ssv[ai][3];
                atomicAdd(stat + row_off + u.pm * BM + ai * HALF + wr * 64 + 16 * fq + fr, v); }
        }
    }
};

struct EpiResF {
    static constexpr bool PERM = false, AFTER_DRAIN = false, ROWPERM = false; static constexpr int NPARAM = 0;
    const float* base0; const float* base1; int split_row; float* out; bf16_t* xn; float* stat; int row_off; const bf16_t* bbase;
    __device__ __forceinline__ void operator()(const f32x4 (&acc)[2][2][4][2], const Unit& u, int wr, int wc, int fr, int fq, PG8_LAS unsigned char* pbuf) const {
        const int col0 = u.pn * BM + wc * 32 + 4 * fq;
#pragma unroll
        for (int ai = 0; ai < 2; ++ai)
#pragma unroll
            for (int m = 0; m < 4; ++m) {
                const int r = row_off + u.pm * BM + ai * HALF + wr * 64 + m * 16 + fr;
                const float* b = (r < split_row) ? base0 + (size_t)r * 1024 : base1 + (size_t)(r - split_row) * 1024;
                float* o = out + (size_t)r * 1024; float ss = 0.f;
#pragma unroll
                for (int bj = 0; bj < 2; ++bj)
#pragma unroll
                    for (int n = 0; n < 2; ++n) { const int c = col0 + bj * HALF + n * 16;
                        f32x4 bs;
                        if (bbase) { typedef unsigned u32x2w __attribute__((ext_vector_type(2))); const u32x2w w = *(const u32x2w*)(bbase + (size_t)r * 1024 + c);
                            bs = (f32x4){__builtin_bit_cast(float, w.x << 16), __builtin_bit_cast(float, w.x & 0xffff0000u), __builtin_bit_cast(float, w.y << 16), __builtin_bit_cast(float, w.y & 0xffff0000u)}; }
                        else bs = *(const f32x4*)(b + c);
                        const f32x4 x = bs + acc[ai][bj][m][n]; if (out) *(f32x4*)(o + c) = x;
                        ss += (x[0] * x[0] + x[1] * x[1]) + (x[2] * x[2] + x[3] * x[3]);
                        if (xn) { typedef unsigned u32x2v __attribute__((ext_vector_type(2))); u32x2v w; w.x = cvt_pk_bf16(x[0], x[1]); w.y = cvt_pk_bf16(x[2], x[3]); *(u32x2v*)(xn + (size_t)r * 1024 + c) = w; } }
                if (stat) { ss += __shfl_xor(ss, 16); ss += __shfl_xor(ss, 32); if (fq == 0) atomicAdd(stat + r, ss); }
                asm volatile("" ::: "memory");
            }
    }
};

__device__ __forceinline__ float dpp_shr1(float x) { return __builtin_bit_cast(float, __builtin_amdgcn_mov_dpp(__builtin_bit_cast(int, x), 0x111, 0xf, 0xf, true)); }
__device__ __forceinline__ float dpp_shl1(float x) { return __builtin_bit_cast(float, __builtin_amdgcn_mov_dpp(__builtin_bit_cast(int, x), 0x101, 0xf, 0xf, true)); }
__device__ __forceinline__ float dpp_ror1(float x)  { return __builtin_bit_cast(float, __builtin_amdgcn_mov_dpp(__builtin_bit_cast(int, x), 0x121, 0xf, 0xf, true)); }
__device__ __forceinline__ float dpp_ror15(float x) { return __builtin_bit_cast(float, __builtin_amdgcn_mov_dpp(__builtin_bit_cast(int, x), 0x12F, 0xf, 0xf, true)); }
struct EpiConv {
    static constexpr bool PERM = true, AFTER_DRAIN = false, ROWPERM = true;
    static constexpr int NPARAM = 1;
    bf16_t* ACT; bf16_t* HALO; const float* rstat; int row_off; const float* cw; const float* cb;
    __device__ __forceinline__ void stage_params(const Unit& u, PG8_LAS unsigned char* pbuf, int wr, int wc, int lane) const {
        asm volatile("" : "+v"(lane));
        const int cbase = u.pn * 128 + wc * 32;
        { const float* gp;
          if (lane < 32) gp = rstat + row_off + u.pm * BM + (lane >> 4) * HALF + wr * 64 + 4 * (lane & 15);
          else { const int j = lane - 32; gp = cw + (j >> 4) * 5632 + ((j >> 3) & 1) * 2816 + cbase + 4 * (j & 7); }
          __builtin_amdgcn_global_load_lds((const unsigned*)gp, (PG8_LAS unsigned*)pbuf, 16, 0, 0); }
        if (lane < 32) { const int j = lane; const float* gp = ((j >> 4) ? cb : cw + 2 * 5632) + ((j >> 3) & 1) * 2816 + cbase + 4 * (j & 7);
          __builtin_amdgcn_global_load_lds((const unsigned*)gp, (PG8_LAS unsigned*)(pbuf + 1024), 16, 0, 0); }
    }
    __device__ __forceinline__ void operator()(const f32x4 (&acc)[2][2][4][2], const Unit& u, int wr, int wc, int fr, int fq, PG8_LAS unsigned char* pbuf) const {
        const int a0 = u.pn * 128 + wc * 32 + 8 * fq, ng0 = u.pn * 256 + wc * 32 + 8 * fq;
        f32x4 wgA[2][3], wuA[2][3], bgA[2], buA[2], s4A[2];
#pragma unroll
        for (int ai = 0; ai < 2; ++ai) s4A[ai] = *(const PG8_LAS f32x4*)(pbuf + (ai * 64 + 4 * fr) * 4);
#pragma unroll
        for (int n = 0; n < 2; ++n) { const int cg4 = (2 * fq + n) * 16;
#pragma unroll
            for (int k = 0; k < 2; ++k) { wgA[n][k] = *(const PG8_LAS f32x4*)(pbuf + 512 + k * 256 + cg4); wuA[n][k] = *(const PG8_LAS f32x4*)(pbuf + 512 + k * 256 + 128 + cg4); }
            wgA[n][2] = *(const PG8_LAS f32x4*)(pbuf + 1024 + cg4); wuA[n][2] = *(const PG8_LAS f32x4*)(pbuf + 1024 + 128 + cg4);
            bgA[n] = *(const PG8_LAS f32x4*)(pbuf + 1280 + cg4); buA[n] = *(const PG8_LAS f32x4*)(pbuf + 1280 + 128 + cg4); }
#pragma unroll
        for (int ai = 0; ai < 2; ++ai) {
            const int R0 = u.pm * BM + ai * HALF + wr * 64;
            float sc[4];
            { const f32x4 s4 = s4A[ai];
#pragma unroll
              for (int m = 0; m < 4; ++m) sc[m] = __builtin_amdgcn_rsqf(s4[m] * (1.0f / 1024.0f) + 1e-6f); }
            if (fr == 0 || fr == 15) { bf16_t* hb = HALO + (size_t)(R0 >> 6) * 4 * 5632 + ng0;
#pragma unroll
              for (int bj = 0; bj < 2; ++bj)
#pragma unroll
                  for (int k = 0; k < 2; ++k) {
                      const bool top = (fr == 0); const float scs = top ? sc[k] : sc[k + 2];
                      f32x4 v0, v1;
#pragma unroll
                      for (int e = 0; e < 4; ++e) { v0[e] = (top ? acc[ai][bj][k][0][e] : acc[ai][bj][k + 2][0][e]) * scs; v1[e] = (top ? acc[ai][bj][k][1][e] : acc[ai][bj][k + 2][1][e]) * scs; }
                      u32x4 w; w.x = cvt_pk_bf16(v0[0], v0[1]); w.y = cvt_pk_bf16(v0[2], v0[3]); w.z = cvt_pk_bf16(v1[0], v1[1]); w.w = cvt_pk_bf16(v1[2], v1[3]);
                      *(u32x4*)(hb + (size_t)(top ? k : k + 2) * 5632 + bj * HALF) = w; } }
            unsigned ow[4][4];
#pragma unroll
            for (int n = 0; n < 2; ++n) {
                const f32x4 (&wg)[3] = wgA[n]; const f32x4 (&wu)[3] = wuA[n]; const f32x4 bg = bgA[n], bu = buA[n];
                float keep[4];
#pragma unroll
                for (int j = 0; j < 4; ++j) {
                    float xg[6], xu[6];
#pragma unroll
                    for (int m = 0; m < 4; ++m) { xg[m + 1] = acc[ai][0][m][n][j] * sc[m]; xu[m + 1] = acc[ai][1][m][n][j] * sc[m]; }
                    xg[0] = dpp_shr1(xg[4]); xg[5] = dpp_shl1(xg[1]); xu[0] = dpp_shr1(xu[4]); xu[5] = dpp_shl1(xu[1]);
#pragma unroll
                    for (int m = 0; m < 4; ++m) {
                        const float g = xg[m] * wg[0][j] + xg[m + 1] * wg[1][j] + xg[m + 2] * wg[2][j] + bg[j];
                        const float uu = xu[m] * wu[0][j] + xu[m + 1] * wu[1][j] + xu[m + 2] * wu[2][j] + bu[j];
                        const float av = g * __builtin_amdgcn_rcpf(1.0f + __builtin_amdgcn_exp2f(-1.4426950408889634f * g)) * uu;
                        if (j & 1) ow[m][2 * n + (j >> 1)] = cvt_pk_bf16(keep[m], av); else keep[m] = av;
                    }
                    __builtin_amdgcn_sched_barrier(0);
                }
            }
#pragma unroll
            for (int m = 0; m < 4; ++m) {
                u32x4 w; w.x = ow[m][0]; w.y = ow[m][1]; w.z = ow[m][2]; w.w = ow[m][3];
                const bool edge = (m == 0 && fr == 0) || (m == 3 && fr == 15);
                if (!edge) *(u32x4*)(ACT + (size_t)(R0 + 4 * fr + m) * 2816 + a0) = w;
            }
            asm volatile("" ::: "memory");
        }
    }
};

struct EpiQKV {
    static constexpr bool PERM = false, AFTER_DRAIN = false, ROWPERM = false; static constexpr int NPARAM = 0;
    bf16_t* O; const float* rstat; const float* qg; const float* kg;
    __device__ __forceinline__ void operator()(const f32x4 (&acc)[2][2][4][2], const Unit& u, int wr, int wc, int fr, int fq, PG8_LAS unsigned char* pbuf) const {
        typedef unsigned u32x2v __attribute__((ext_vector_type(2)));
        if (u.pn == 5) {
            const int col0 = 1280 + wc * 32 + 4 * fq;
#pragma unroll
            for (int ai = 0; ai < 2; ++ai)
#pragma unroll
                for (int m = 0; m < 4; ++m) { const int r = u.pm * BM + ai * HALF + wr * 64 + m * 16 + fr; const float sc = __builtin_amdgcn_rsqf(rstat[r] * (1.0f / 1024.0f) + 1e-6f);
#pragma unroll
                    for (int bj = 0; bj < 2; ++bj)
#pragma unroll
                        for (int n = 0; n < 2; ++n) { const f32x4 v = acc[ai][bj][m][n] * sc; u32x2v w; w.x = cvt_pk_bf16(v[0], v[1]); w.y = cvt_pk_bf16(v[2], v[3]);
                            *(u32x2v*)(O + (size_t)r * 1536 + col0 + bj * HALF + n * 16) = w; } }
            return;
        }
        const int head = u.pn * 4 + wc; const bool isq = u.pn < 4; const float* gp = isq ? qg : kg;
        f32x4 gn[2][2];
#pragma unroll
        for (int bj = 0; bj < 2; ++bj)
#pragma unroll
            for (int n = 0; n < 2; ++n) gn[bj][n] = *(const f32x4*)(gp + 32 * bj + 16 * n + 4 * fq);
        float invf[4];
#pragma unroll
        for (int j = 0; j < 4; ++j) invf[j] = __builtin_amdgcn_exp2f(-(float)(4 * fq + j) * 0.830482024f) * 0.15915494309189535f;
        const float osc = isq ? 0.125f * 1.4426950408889634f : 1.0f;
#pragma unroll
        for (int ai = 0; ai < 2; ++ai)
#pragma unroll
            for (int m = 0; m < 4; ++m) {
                const int r = u.pm * BM + ai * HALF + wr * 64 + m * 16 + fr; const float sc = __builtin_amdgcn_rsqf(rstat[r] * (1.0f / 1024.0f) + 1e-6f);
                f32x4 q[2][2]; float ss = 0.f;
#pragma unroll
                for (int bj = 0; bj < 2; ++bj)
#pragma unroll
                    for (int n = 0; n < 2; ++n) { q[bj][n] = acc[ai][bj][m][n] * sc; const f32x4 x = q[bj][n]; ss += (x[0] * x[0] + x[1] * x[1]) + (x[2] * x[2] + x[3] * x[3]); }
                ss += __shfl_xor(ss, 16); ss += __shfl_xor(ss, 32);
                const float rn = __builtin_amdgcn_rsqf(ss * (1.0f / 64.0f) + 1e-6f);
                const int t = (r < 16384) ? (r & 8191) : (r & 2047);
                bf16_t* op = O + (size_t)r * 1536 + head * 64 + 4 * fq;
#pragma unroll
                for (int bj = 0; bj < 2; ++bj) {
                    float pos = (float)(bj ? (t & 63) : (t >> 6)); asm volatile("" : "+v"(pos));
                    float oa[4], ob[4];
#pragma unroll
                    for (int j = 0; j < 4; ++j) {
                        float rev = pos * invf[j]; rev -= __builtin_floorf(rev);
                        const float sn = __builtin_amdgcn_sinf(rev), cs = __builtin_amdgcn_cosf(rev);
                        const float a = q[bj][0][j] * rn * gn[bj][0][j], b = q[bj][1][j] * rn * gn[bj][1][j];
                        oa[j] = (a * cs - b * sn) * osc; ob[j] = (b * cs + a * sn) * osc;
                    }
                    u32x2v wa, wb; wa.x = cvt_pk_bf16(oa[0], oa[1]); wa.y = cvt_pk_bf16(oa[2], oa[3]); wb.x = cvt_pk_bf16(ob[0], ob[1]); wb.y = cvt_pk_bf16(ob[2], ob[3]);
                    *(u32x2v*)(op + 32 * bj) = wa; *(u32x2v*)(op + 32 * bj + 16) = wb;
                    __builtin_amdgcn_sched_barrier(0);
                }
            }
    }
};
template <class Epi, class Sched, bool ALIGN_EPI = false, bool SP2 = false>
__device__ __forceinline__ void gemm_phase(PG8_LAS unsigned char* lds, Gemm g, const Sched& S, const Epi& E) {
    int tid_ = threadIdx.x; asm volatile("" : "+v"(tid_));
    asm volatile("" : "+s"(g.A), "+s"(g.Bt));
    const int tid = tid_, wid = __builtin_amdgcn_readfirstlane(tid >> 6), lane = tid & 63, wr = wid >> 2, wc = wid & 3, fr = lane & 15, fq = lane >> 4;
    const int K = g.K, nt = K / BK;
    unsigned voffA[2], voffB[2];
#pragma unroll
    for (int i = 0; i < 2; ++i) { int R, C; stage_rc(tid * 16 + i * 8192, R, C); const int Rb = Epi::PERM ? ((R & ~31) + perm32(R & 31)) : R;
        const int Ra = Epi::ROWPERM ? ((R & ~63) + 4 * (R & 15) + ((R >> 4) & 3)) : R;
        voffA[i] = (unsigned)(Ra * g.lda + C) * 2u; voffB[i] = (unsigned)(Rb * g.ldb + C) * 2u; }
    const size_t kstep = (size_t)(BK * 2);
    const size_t hstepA = (size_t)HALF * g.lda * 2, hstepB = (size_t)HALF * g.ldb * 2;
    const size_t tstepA = 2 * hstepA, tstepB = 2 * hstepB;
    const unsigned ldsw = (unsigned)wid * 1024u;
    const int aoff = lds_byte(wr * 64 + fr, fq * 8), boff = lds_byte(wc * 32 + fr, fq * 8);
#define PG8_SA(b, h) (((b) * 2 + (h)) * HTB)
#define PG8_SB(b, h) ((4 + (b) * 2 + (h)) * HTB)
#define PG8_STAGE(bufoff, gbase, voff) do { _Pragma("unroll") for (int _i = 0; _i < 2; ++_i) \
        __builtin_amdgcn_global_load_lds((const unsigned*)((const char*)(gbase) + (voff)[_i]), (PG8_LAS unsigned*)(lds + (bufoff) + ldsw + _i * 8192), 16, 0, 0); } while (0)
#define PG8_LDA(dst, b, h) do { _Pragma("unroll") for (int m = 0; m < 4; ++m) _Pragma("unroll") for (int k = 0; k < 2; ++k) dst[m][k] = *(const PG8_LAS bf16x8*)(lds + PG8_SA(b, h) + aoff + m * 2048 + k * 1024); } while (0)
#define PG8_LDB(dst, b, h) do { _Pragma("unroll") for (int n = 0; n < 2; ++n) _Pragma("unroll") for (int k = 0; k < 2; ++k) dst[n][k] = *(const PG8_LAS bf16x8*)(lds + PG8_SB(b, h) + boff + n * 2048 + k * 1024); } while (0)
#define PG8_MMA(ai, bj, At, Bt) do { __builtin_amdgcn_s_setprio(1); _Pragma("unroll") for (int m = 0; m < 4; ++m) _Pragma("unroll") for (int n = 0; n < 2; ++n) _Pragma("unroll") for (int k = 0; k < 2; ++k) \
        acc[ai][bj][m][n] = __builtin_amdgcn_mfma_f32_16x16x32_bf16(Bt[n][k], At[m][k], acc[ai][bj][m][n], 0, 0, 0); __builtin_amdgcn_s_setprio(0); } while (0)
#define PG8_WAIT_V(n) asm volatile("s_waitcnt vmcnt(" #n ")" ::: "memory")
#define PG8_WAIT_L(n) asm volatile("s_waitcnt lgkmcnt(" #n ")" ::: "memory")
#define PG8_BAR __builtin_amdgcn_s_barrier()
#define PG8_SCHED __builtin_amdgcn_sched_barrier(0)
    Unit cur, nxt; int ui = 0;
    constexpr int PBLK_OFF = STAGE_BYTES + 1024, PBLK_WAVE = 1536, PBLK_ALL = 8 * PBLK_WAVE;
    PG8_LAS unsigned char* const pblk = lds + PBLK_OFF + wid * PBLK_WAVE; int upar = 0;
    if (!S.next(0, cur)) return;
    f32x4 acc[2][2][4][2];
#pragma unroll
    for (int a = 0; a < 2; ++a)
#pragma unroll
        for (int b = 0; b < 2; ++b)
#pragma unroll
            for (int m = 0; m < 4; ++m)
#pragma unroll
                for (int n = 0; n < 2; ++n) acc[a][b][m][n] = (f32x4){0.f, 0.f, 0.f, 0.f};
    bf16x8 At[4][2], B0[2][2], B1[2][2];
    const char* cA = (const char*)g.A + (size_t)cur.pm * tstepA; const char* cB = (const char*)g.Bt + (size_t)cur.pn * tstepB;
    S.a_ready(cur);
    if constexpr (Epi::NPARAM > 0) E.stage_params(cur, pblk, wr, wc, lane);
    if constexpr (SP2) {
        PG8_STAGE(PG8_SB(0, 0), cB, voffB); PG8_STAGE(PG8_SB(0, 1), cB + hstepB, voffB); PG8_STAGE(PG8_SA(0, 0), cA, voffA); PG8_STAGE(PG8_SA(0, 1), cA + hstepA, voffA);
        if (wr == 1) PG8_BAR;
        PG8_WAIT_V(2); PG8_BAR;
        PG8_STAGE(PG8_SB(1, 0), cB + kstep, voffB); PG8_STAGE(PG8_SA(1, 0), cA + kstep, voffA); PG8_STAGE(PG8_SB(1, 1), cB + hstepB + kstep, voffB);
        PG8_WAIT_V(6); PG8_BAR;
    } else {
        PG8_STAGE(PG8_SB(0, 0), cB, voffB); PG8_STAGE(PG8_SA(0, 0), cA, voffA); PG8_STAGE(PG8_SB(0, 1), cB + hstepB, voffB); PG8_STAGE(PG8_SA(0, 1), cA + hstepA, voffA);
        if (wr == 1) PG8_BAR;
        PG8_WAIT_V(4); PG8_BAR;
        PG8_STAGE(PG8_SB(1, 0), cB + kstep, voffB); PG8_STAGE(PG8_SA(1, 0), cA + kstep, voffA); PG8_STAGE(PG8_SB(1, 1), cB + hstepB + kstep, voffB);
        PG8_WAIT_V(6); PG8_BAR;
    }
    for (;;) {
        const bool has_next = S.next(ui + 1, nxt);
        const char* nA = has_next ? (const char*)g.A + (size_t)nxt.pm * tstepA : cA; const char* nB = has_next ? (const char*)g.Bt + (size_t)nxt.pn * tstepB : cB;
        for (int t = 0; t < nt; t += 2) {
            const bool last = (t == nt - 2);
            const char* a1 = cA + (size_t)(t + 1) * kstep;
            const char* a2 = last ? nA : cA + (size_t)(t + 2) * kstep; const char* b2 = last ? nB : cB + (size_t)(t + 2) * kstep;
            const char* a3 = a2 + kstep; const char* b3 = b2 + kstep;
            if (last && has_next) S.a_ready(nxt);
            if constexpr (SP2) {
            PG8_LDB(B0, 0, 0); PG8_LDB(B1, 0, 1); PG8_SCHED; PG8_LDA(At, 0, 0); PG8_STAGE(PG8_SA(1, 1), a1 + hstepA, voffA);
            PG8_WAIT_V(8); PG8_WAIT_L(0); PG8_BAR; PG8_MMA(0, 0, At, B0); PG8_MMA(0, 1, At, B1); PG8_BAR; PG8_SCHED;
            PG8_LDA(At, 0, 1); PG8_STAGE(PG8_SB(0, 0), b2, voffB); PG8_STAGE(PG8_SB(0, 1), b2 + hstepB, voffB); PG8_STAGE(PG8_SA(0, 0), a2, voffA);
            PG8_WAIT_V(8); PG8_WAIT_L(0); PG8_BAR; PG8_MMA(1, 0, At, B0); PG8_MMA(1, 1, At, B1); PG8_BAR; PG8_SCHED;
            PG8_LDB(B0, 1, 0); PG8_LDB(B1, 1, 1); PG8_SCHED; PG8_LDA(At, 1, 0); PG8_STAGE(PG8_SA(0, 1), a2 + hstepA, voffA);
            PG8_WAIT_V(8); PG8_WAIT_L(0); PG8_BAR; PG8_MMA(0, 0, At, B0); PG8_MMA(0, 1, At, B1); PG8_BAR; PG8_SCHED;
            PG8_LDA(At, 1, 1); PG8_STAGE(PG8_SB(1, 0), b3, voffB); PG8_STAGE(PG8_SB(1, 1), b3 + hstepB, voffB); PG8_STAGE(PG8_SA(1, 0), a3, voffA);
            PG8_WAIT_V(8); PG8_WAIT_L(0); PG8_BAR; PG8_MMA(1, 0, At, B0); PG8_MMA(1, 1, At, B1); PG8_BAR; PG8_SCHED;
            } else {
            PG8_LDB(B0, 0, 0); PG8_SCHED; PG8_LDA(At, 0, 0); PG8_STAGE(PG8_SA(1, 1), a1 + hstepA, voffA);
            PG8_WAIT_L(8); PG8_BAR; PG8_WAIT_L(0); PG8_MMA(0, 0, At, B0); PG8_BAR; PG8_SCHED;
            PG8_LDB(B1, 0, 1); PG8_STAGE(PG8_SB(0, 0), b2, voffB);
            PG8_BAR; PG8_WAIT_L(0); PG8_MMA(0, 1, At, B1); PG8_BAR;
            PG8_LDA(At, 0, 1); PG8_STAGE(PG8_SA(0, 0), a2, voffA);
            PG8_BAR; PG8_WAIT_L(0); PG8_MMA(1, 0, At, B0); PG8_BAR; PG8_SCHED;
            PG8_STAGE(PG8_SB(0, 1), b2 + hstepB, voffB);
            PG8_WAIT_V(6); PG8_BAR; PG8_MMA(1, 1, At, B1); PG8_BAR;
            PG8_LDB(B0, 1, 0); PG8_SCHED; PG8_LDA(At, 1, 0); PG8_STAGE(PG8_SA(0, 1), a2 + hstepA, voffA);
            PG8_WAIT_L(8); PG8_BAR; PG8_WAIT_L(0); PG8_MMA(0, 0, At, B0); PG8_BAR; PG8_SCHED;
            PG8_LDB(B1, 1, 1); PG8_STAGE(PG8_SB(1, 0), b3, voffB);
            PG8_BAR; PG8_WAIT_L(0); PG8_MMA(0, 1, At, B1); PG8_BAR;
            PG8_LDA(At, 1, 1); PG8_STAGE(PG8_SA(1, 0), a3, voffA);
            PG8_BAR; PG8_WAIT_L(0); PG8_MMA(1, 0, At, B0); PG8_BAR; PG8_SCHED;
            PG8_STAGE(PG8_SB(1, 1), b3 + hstepB, voffB);
            PG8_WAIT_V(6); PG8_BAR; PG8_MMA(1, 1, At, B1); PG8_BAR;
            }
        }
        if constexpr (ALIGN_EPI) { if (wr == 0) PG8_BAR; }
        if constexpr (!Epi::AFTER_DRAIN) { int fr_e = fr, fq_e = fq; asm volatile("" : "+v"(fr_e), "+v"(fq_e));
            E(acc, cur, wr, wc, fr_e, fq_e, pblk + upar * PBLK_ALL); upar ^= 1; S.done(cur);
            if constexpr (Epi::NPARAM > 0) { if (has_next) E.stage_params(nxt, pblk + upar * PBLK_ALL, wr, wc, (fq_e << 4) | fr_e); } }
        if (!has_next) break;
#pragma unroll
        for (int a = 0; a < 2; ++a)
#pragma unroll
            for (int b = 0; b < 2; ++b)
#pragma unroll
                for (int m = 0; m < 4; ++m)
#pragma unroll
                    for (int n = 0; n < 2; ++n) acc[a][b][m][n] = (f32x4){0.f, 0.f, 0.f, 0.f};
        cur = nxt; cA = nA; cB = nB; ++ui;
        if constexpr (ALIGN_EPI) { if (wr == 1) PG8_BAR; }
    }
    PG8_WAIT_V(0);
    if constexpr (!ALIGN_EPI) { if (wr == 0) PG8_BAR; }
    PG8_BAR;
    if constexpr (Epi::AFTER_DRAIN) { E.fused(acc, cur, wr, wc, fr, fq, lds, wid, lane); S.done(cur); }
#undef PG8_SA
#undef PG8_SB
#undef PG8_STAGE
#undef PG8_LDA
#undef PG8_LDB
#undef PG8_MMA
#undef PG8_WAIT_V
#undef PG8_WAIT_L
#undef PG8_BAR
#undef PG8_SCHED
}
}
#include <hip/hip_bf16.h>
#include <cmath>
namespace attn_body {
using bf16=__hip_bfloat16;
using bf16x8=__attribute__((ext_vector_type(8)))short;
using s16x4=__attribute__((ext_vector_type(4)))short;
using f32x16=__attribute__((ext_vector_type(16)))float;
using u32x4=__attribute__((ext_vector_type(4)))unsigned;
constexpr int D=64,DM=1536;
constexpr int NW=8,QBLK=32,QB=QBLK*NW,KVBLK=64;
constexpr int ATTN_PITCH=DM, ATTN_UNIT_ROWS=QB;
__device__ __forceinline__ int crow(int r,int hi){return (r&3)+8*(r>>2)+4*hi;}
#define SBAR() __builtin_amdgcn_sched_barrier(0)
__device__ __forceinline__ void cmask(f32x16&p0,f32x16&p1,int jb,int qrel,int hi){
  const float NEG=-INFINITY; int kb=64*jb+4*hi;
  #pragma unroll
  for(int r=0;r<16;++r){int kv=kb+(r&3)+8*(r>>2); if(kv>qrel)p0[r]=NEG; if(kv+32>qrel)p1[r]=NEG;}
}

constexpr int NSLOT=3, SLOTB=8192;
constexpr int LDS_K=0, LDS_V=NSLOT*SLOTB, LDS_WS=2*NSLOT*SLOTB, LDS_OST=LDS_WS+NW*64*4, LDS_BYTES=LDS_OST+NW*4096;
constexpr float C2=0.125f*1.4426950408889634f;
__device__ __forceinline__ void glds16(const void*gsrc,unsigned lds_dst){unsigned keep;
  asm volatile("s_mov_b32 %0, m0\n\ts_mov_b32 m0, %2\n\ts_nop 0\n\tglobal_load_lds_dwordx4 %1, off\n\ts_mov_b32 m0, %0":"=&s"(keep):"v"(gsrc),"s"(lds_dst):"memory");}
__device__ __forceinline__ float max3f(float a,float b,float c){float r;asm("v_max3_f32 %0, %1, %2, %3":"=v"(r):"v"(a),"v"(b),"v"(c));return r;}
__device__ __forceinline__ float max2f(float a,float b){float r;asm("v_max_f32_e32 %0, %1, %2":"=v"(r):"v"(a),"v"(b));return r;}
__device__ __forceinline__ float fadd_s(float a,float b){float r;asm("v_add_f32_e32 %0, %1, %2":"=v"(r):"v"(a),"v"(b));return r;}
__device__ __forceinline__ float fsub_s(float a,float b){float r;asm("v_sub_f32_e32 %0, %1, %2":"=v"(r):"v"(a),"v"(b));return r;}
typedef float f32x2_t __attribute__((ext_vector_type(2))); typedef __bf16 bf16x2_t __attribute__((ext_vector_type(2)));
__device__ __forceinline__ unsigned cvtpk_s(float lo,float hi){f32x2_t v={lo,hi};bf16x2_t b=__builtin_convertvector(v,bf16x2_t);return __builtin_bit_cast(unsigned,b);}
#define WAIT_BAR(N) asm volatile("s_waitcnt vmcnt(" #N ") lgkmcnt(0)\n\ts_barrier":::"memory")

__device__ __forceinline__ void qkt(f32x16&p0,f32x16&p1,const char*Kslot,const bf16x8*qr,const f32x16&negm,int r32,int hi){
  const char*kb=Kslot+hi*1024+r32*16;
  #pragma unroll
  for(int d0=0;d0<4;++d0){
    const bf16x8 b0=*reinterpret_cast<const bf16x8*>(kb+d0*2048);
    const bf16x8 b1=*reinterpret_cast<const bf16x8*>(kb+d0*2048+512);
    if(d0==0){p0=__builtin_amdgcn_mfma_f32_32x32x16_bf16(b0,qr[0],negm,0,0,0);p1=__builtin_amdgcn_mfma_f32_32x32x16_bf16(b1,qr[0],negm,0,0,0);}
    else{p0=__builtin_amdgcn_mfma_f32_32x32x16_bf16(b0,qr[d0],p0,0,0,0);p1=__builtin_amdgcn_mfma_f32_32x32x16_bf16(b1,qr[d0],p1,0,0,0);}}
}
typedef __attribute__((address_space(3))) const char* lds_cptr;
typedef short v4i16_t __attribute__((ext_vector_type(4)));
__device__ __forceinline__ void kload8(bf16x8*kf,lds_cptr kp){
  kf[0]=*(const __attribute__((address_space(3))) bf16x8*)(kp);      kf[1]=*(const __attribute__((address_space(3))) bf16x8*)(kp+512);
  kf[2]=*(const __attribute__((address_space(3))) bf16x8*)(kp+2048); kf[3]=*(const __attribute__((address_space(3))) bf16x8*)(kp+2560);
  kf[4]=*(const __attribute__((address_space(3))) bf16x8*)(kp+4096); kf[5]=*(const __attribute__((address_space(3))) bf16x8*)(kp+4608);
  kf[6]=*(const __attribute__((address_space(3))) bf16x8*)(kp+6144); kf[7]=*(const __attribute__((address_space(3))) bf16x8*)(kp+6656);
}
__device__ __forceinline__ void kload2(bf16x8*kf,lds_cptr kp,int j){ kf[2*j]=*(const __attribute__((address_space(3))) bf16x8*)(kp+j*2048); kf[2*j+1]=*(const __attribute__((address_space(3))) bf16x8*)(kp+j*2048+512); }
__device__ __forceinline__ s16x4 vtr(lds_cptr p){ return __builtin_bit_cast(s16x4,__builtin_amdgcn_ds_read_tr16_b64_v4i16((__attribute__((address_space(3))) v4i16_t*)p)); }
__device__ __forceinline__ float rowmax(const f32x16&p0,const f32x16&p1){
  float a=max3f(p0[0],p0[1],p1[0]),b=max3f(p0[2],p0[3],p1[1]);a=max3f(a,p1[2],p1[3]);
  #pragma unroll
  for(int r=4;r<16;r+=4){a=max3f(a,p0[r],p0[r+1]);b=max3f(b,p0[r+2],p0[r+3]);a=max3f(a,p1[r],p1[r+1]);b=max3f(b,p1[r+2],p1[r+3]);}
  const float m=max2f(a,b);
  auto rr=__builtin_amdgcn_permlane32_swap(__float_as_uint(m),__float_as_uint(m),false,false);
  return max2f(__uint_as_float(rr[0]),__uint_as_float(rr[1]));
}
__device__ __forceinline__ void pv(f32x16*o,int vb,bf16x8 pa0,bf16x8 pa1,bf16x8 pa2,bf16x8 pa3){
  #pragma unroll
  for(int d0=0;d0<2;++d0){s16x4 lo[4],hi[4];
    #pragma unroll
    for(int ks=0;ks<4;++ks){
      asm volatile("ds_read_b64_tr_b16 %0,%1 offset:%c2":"=&v"(lo[ks]):"v"(vb),"i"(d0*4096+ks*1024):"memory");
      asm volatile("ds_read_b64_tr_b16 %0,%1 offset:%c2":"=&v"(hi[ks]):"v"(vb),"i"(d0*4096+ks*1024+512):"memory");}
    asm volatile("s_waitcnt lgkmcnt(0)":::"memory");SBAR();
    #define PK(k) (bf16x8){lo[k][0],lo[k][1],lo[k][2],lo[k][3],hi[k][0],hi[k][1],hi[k][2],hi[k][3]}
    o[d0]=__builtin_amdgcn_mfma_f32_32x32x16_bf16(pa0,PK(0),o[d0],0,0,0);
    o[d0]=__builtin_amdgcn_mfma_f32_32x32x16_bf16(pa1,PK(1),o[d0],0,0,0);
    o[d0]=__builtin_amdgcn_mfma_f32_32x32x16_bf16(pa2,PK(2),o[d0],0,0,0);
    o[d0]=__builtin_amdgcn_mfma_f32_32x32x16_bf16(pa3,PK(3),o[d0],0,0,0);
    #undef PK
  }
}

#ifndef ATTN_STORE16
#define ATTN_STORE16(p,v) (*(u32x4*)(p)=(v))
#endif
template<int THRL, bool NOMAX> __device__ __forceinline__ void attn_unit(const bf16*Qu,const bf16*__restrict__ Kh,const bf16*__restrict__ Vh,bf16*Ou,const int NT,char*shm){
  const int tid=threadIdx.x,lane=tid&63,r32=lane&31,hi=lane>>5; const int wid=__builtin_amdgcn_readfirstlane(tid>>6);
  const bf16*Qw=Qu+(long)(wid*QBLK)*DM;
  const unsigned lds0=(unsigned)(uintptr_t)shm;
  float*wsf=(float*)(shm+LDS_WS)+wid*64;
  const bf16*ksrc=Kh+(long)lane*DM+wid*8;
  const bf16*vsrc=Vh+(long)(16*(wid&3)+(lane>>2))*DM+(wid>>2)*32+(lane&3)*8;
  const unsigned kdst=lds0+LDS_K+wid*1024, vdst=lds0+LDS_V+wid*1024;
  #define DMA_K(t,slot) glds16(ksrc+(long)(t)*KVBLK*DM,(unsigned)__builtin_amdgcn_readfirstlane(kdst+(slot)))
  #define DMA_V(t,slot) glds16(vsrc+(long)(t)*KVBLK*DM,(unsigned)__builtin_amdgcn_readfirstlane(vdst+(slot)))
  const int vb0=(int)(lds0+LDS_V)+((lane>>4)&1)*32+(lane&3)*8+(4*hi+((lane&15)>>2))*64;
  const char*Kbase=shm+LDS_K; bf16x8 kf[8];
  const lds_cptr shm3=(lds_cptr)shm; const lds_cptr kp0=shm3+LDS_K+hi*1024+r32*16; const lds_cptr vp0=shm3+LDS_V+((lane>>4)&1)*32+(lane&3)*8+(4*hi+((lane&15)>>2))*64;
  DMA_K(0,0);DMA_V(0,0);DMA_K(1,SLOTB);
  bf16x8 qr[4];
  #pragma unroll
  for(int d0=0;d0<4;++d0)qr[d0]=*reinterpret_cast<const bf16x8*>(&Qw[(long)r32*DM+d0*16+hi*8]);
  float mhat=0.f,l_reg=0.f;f32x16 o[2];o[0]=f32x16{};o[1]=f32x16{};f32x16 negm=f32x16{};asm volatile("":"+v"(negm));
  const int qrel=wid*QBLK+r32;
  #define CMASK(P0,P1,t) do{}while(0)
  bool resc=false;
  #define START(P0,P1) do{ const float rm=rowmax(P0,P1); resc=false; \
    { const float dl=rm; mhat=fadd_s(mhat,dl); \
      _Pragma("unroll") for(int r=0;r<16;++r){P0[r]=fsub_s(P0[r],dl);P1[r]=fsub_s(P1[r],dl);} \
      _Pragma("unroll") for(int r=0;r<16;++r)negm[r]=-mhat; asm volatile("":"+v"(negm)); } \
    _Pragma("unroll") for(int r=0;r<16;++r)P0[r]=__builtin_amdgcn_exp2f(P0[r]); }while(0)
  #define RESC() do{ if(resc){ asm volatile("s_waitcnt lgkmcnt(0)":::"memory"); \
      _Pragma("unroll") for(int d_=0;d_<2;++d_) _Pragma("unroll") for(int r=0;r<16;++r)o[d_][r]*=wsf[crow(r,hi)]; } }while(0)
  f32x16 pA0,pA1,pB0,pB1;
  int sl_prev=0,sl_cur=0,sl_next=SLOTB;
  #define ROT() do{sl_prev=sl_cur;sl_cur=sl_next;sl_next=(sl_next==(NSLOT-1)*SLOTB)?0:sl_next+SLOTB;}while(0)
  DMA_K(2,2*SLOTB);
  WAIT_BAR(3);
  qkt(pA0,pA1,Kbase,qr,negm,r32,hi);asm volatile("s_nop 15\n\ts_nop 7":"+v"(pA0),"+v"(pA1));CMASK(pA0,pA1,0);
  START(pA0,pA1);
  _Pragma("unroll") for(int r=0;r<16;++r)pA1[r]=__builtin_amdgcn_exp2f(pA1[r]);
  WAIT_BAR(0);
  DMA_K(3,0);DMA_V(1,SLOTB);
  ROT();
  kload8(kf,kp0+sl_cur);
  WAIT_BAR(2);
  s16x4 vlo[8],vhi[8]; u32x4 pw0,pw1,pw2,pw3;
  #define PKW(P,B) cvtpk_s(P[B],P[B+1])
  #define PAF(k) __builtin_bit_cast(bf16x8,pw##k)
  #define VFR(i) (bf16x8){vlo[i][0],vlo[i][1],vlo[i][2],vlo[i][3],vhi[i][0],vhi[i][1],vhi[i][2],vhi[i][3]}
  #define PIN(x) asm volatile("":"+v"(x))
  #define MX3(a,b,c) __builtin_fmaxf(__builtin_fmaxf((a),(b)),(c))
  #define GAPA(MF,A0,A1,A2,A3,W0,W1,PW) do{ MF; sacc+=A0; sacc+=A1; sacc+=A2; sacc+=A3; PIN(sacc); W0; W1; PIN(PW); SBAR(); }while(0)
  #define EX(v) __builtin_amdgcn_exp2f(v)
  #define GAPB(MF,X,B) do{ MF; X[B]=EX(X[B]); X[B+1]=EX(X[B+1]); X[B+2]=EX(X[B+2]); X[B+3]=EX(X[B+3]); PIN(X); SBAR(); }while(0)
  #define VRD(i) do{ vlo[i]=vtr(vp_+(((i)>>2)*4096+((i)&3)*1024)); vhi[i]=vtr(vp_+(((i)>>2)*4096+((i)&3)*1024+512)); }while(0)
  #define KRD(G,j) do{ if(G){ kload2(kf,kp0+sl_next,j); SBAR(); } }while(0)
  #define STEP(C0,C1,P0,P1,t,GK,GV,GL) do{ SBAR(); \
    const lds_cptr vp_=vp0+sl_prev; \
    VRD(0); SBAR(); float sacc=(P0[0]+P0[1]); \
    GAPA(C0=__builtin_amdgcn_mfma_f32_32x32x16_bf16(kf[0],qr[0],negm,0,0,0), P0[2],P0[3],P0[4],P0[5],     pw0[0]=PKW(P0,0), pw0[1]=PKW(P0,2), pw0); \
    VRD(4); SBAR(); GAPA(C1=__builtin_amdgcn_mfma_f32_32x32x16_bf16(kf[1],qr[0],negm,0,0,0), P0[6],P0[7],P0[8],P0[9],     pw0[2]=PKW(P0,4), pw0[3]=PKW(P0,6), pw0); \
    VRD(1); SBAR(); GAPA(C0=__builtin_amdgcn_mfma_f32_32x32x16_bf16(kf[2],qr[1],C0,0,0,0),   P0[10],P0[11],P0[12],P0[13], pw1[0]=PKW(P0,8), pw1[1]=PKW(P0,10), pw1); \
    VRD(5); SBAR(); GAPA(C1=__builtin_amdgcn_mfma_f32_32x32x16_bf16(kf[3],qr[1],C1,0,0,0),   P0[14],P0[15],P1[0],P1[1],   pw1[2]=PKW(P0,12),pw1[3]=PKW(P0,14), pw1); \
    VRD(2); SBAR(); GAPA(C0=__builtin_amdgcn_mfma_f32_32x32x16_bf16(kf[4],qr[2],C0,0,0,0),   P1[2],P1[3],P1[4],P1[5],     pw2[0]=PKW(P1,0), pw2[1]=PKW(P1,2), pw2); \
    VRD(6); SBAR(); GAPA(C1=__builtin_amdgcn_mfma_f32_32x32x16_bf16(kf[5],qr[2],C1,0,0,0),   P1[6],P1[7],P1[8],P1[9],     pw2[2]=PKW(P1,4), pw2[3]=PKW(P1,6), pw2); \
    VRD(3); SBAR(); GAPA(C0=__builtin_amdgcn_mfma_f32_32x32x16_bf16(kf[6],qr[3],C0,0,0,0),   P1[10],P1[11],P1[12],P1[13], pw3[0]=PKW(P1,8), pw3[1]=PKW(P1,10), pw3); \
    VRD(7); SBAR(); GAPA(C1=__builtin_amdgcn_mfma_f32_32x32x16_bf16(kf[7],qr[3],C1,0,0,0),   P1[14],P1[15],0.f,0.f,       pw3[2]=PKW(P1,12),pw3[3]=PKW(P1,14), pw3); \
    l_reg+=sacc; \
    if(GK){DMA_K((t)+3,sl_cur);} if(GV){DMA_V((t)+1,sl_next);} \
    CMASK(C0,C1,t); \
    if constexpr (!NOMAX) { float a=MX3(C0[0],C0[1],C1[0]),b=MX3(C0[2],C0[3],C1[1]); a=MX3(a,C1[2],C1[3]); \
      _Pragma("unroll") for(int r=4;r<16;r+=4){a=MX3(a,C0[r],C0[r+1]);b=MX3(b,C0[r+2],C0[r+3]);a=MX3(a,C1[r],C1[r+1]);b=MX3(b,C1[r+2],C1[r+3]);} \
      float rm=__builtin_fmaxf(a,b); { auto rr=__builtin_amdgcn_permlane32_swap(__float_as_uint(rm),__float_as_uint(rm),false,false); rm=__builtin_fmaxf(__uint_as_float(rr[0]),__uint_as_float(rr[1])); } \
      resc=false; \
      if(__builtin_expect(__any(rm>(float)THRL),0)){ const float dl=__builtin_fmaxf(rm,0.f); mhat+=dl; \
        _Pragma("unroll") for(int r=0;r<16;++r){C0[r]-=dl;C1[r]-=dl;} \
        _Pragma("unroll") for(int r=0;r<16;++r)negm[r]=-mhat; asm volatile("":"+v"(negm)); \
        const float f=__builtin_amdgcn_exp2f(-dl); l_reg*=f; if(hi==0)wsf[r32]=f; resc=true; } } \
    SBAR(); \
    GAPB(o[0]=__builtin_amdgcn_mfma_f32_32x32x16_bf16(PAF(0),VFR(0),o[0],0,0,0), C0,0); \
    GAPB(o[1]=__builtin_amdgcn_mfma_f32_32x32x16_bf16(PAF(0),VFR(4),o[1],0,0,0), C0,4); \
    KRD(GL,0); GAPB(o[0]=__builtin_amdgcn_mfma_f32_32x32x16_bf16(PAF(1),VFR(1),o[0],0,0,0), C0,8); \
    KRD(GL,1); GAPB(o[1]=__builtin_amdgcn_mfma_f32_32x32x16_bf16(PAF(1),VFR(5),o[1],0,0,0), C0,12); \
    KRD(GL,2); GAPB(o[0]=__builtin_amdgcn_mfma_f32_32x32x16_bf16(PAF(2),VFR(2),o[0],0,0,0), C1,0); \
    KRD(GL,3); GAPB(o[1]=__builtin_amdgcn_mfma_f32_32x32x16_bf16(PAF(2),VFR(6),o[1],0,0,0), C1,4); \
    GAPB(o[0]=__builtin_amdgcn_mfma_f32_32x32x16_bf16(PAF(3),VFR(3),o[0],0,0,0), C1,8); \
    GAPB(o[1]=__builtin_amdgcn_mfma_f32_32x32x16_bf16(PAF(3),VFR(7),o[1],0,0,0), C1,12); \
    }while(0)
  int t=1;
  #undef CMASK
  #define CMASK(P0,P1,t) do{}while(0)
  for(;t+5<NT;t+=2){
    STEP(pB0,pB1,pA0,pA1,t,true,true,true);     WAIT_BAR(2); RESC(); ROT();
    STEP(pA0,pA1,pB0,pB1,t+1,true,true,true);   WAIT_BAR(2); RESC(); ROT();
  }
  #undef CMASK
  #define CMASK(P0,P1,t) do{}while(0)
  #define ENDW(tt) do{ if((tt)+3<NT){WAIT_BAR(2);} else if((tt)+2<NT){WAIT_BAR(1);} else {WAIT_BAR(0);} }while(0)
  for(;t+1<NT;t+=2){
    STEP(pB0,pB1,pA0,pA1,t,(t+3<NT),(t+1<NT),(t+1<NT));       ENDW(t);   RESC(); ROT();
    STEP(pA0,pA1,pB0,pB1,t+1,(t+4<NT),(t+2<NT),(t+2<NT));     ENDW(t+1); RESC(); ROT();
  }
  STEP(pB0,pB1,pA0,pA1,NT-1,false,false,false); RESC();
  { float sacc=pB0[0]+pB0[1]; _Pragma("unroll") for(int r=2;r<16;++r)sacc+=pB0[r]; _Pragma("unroll") for(int r=0;r<16;++r)sacc+=pB1[r]; l_reg+=sacc;
    pw0=(u32x4){PKW(pB0,0),PKW(pB0,2),PKW(pB0,4),PKW(pB0,6)};pw1=(u32x4){PKW(pB0,8),PKW(pB0,10),PKW(pB0,12),PKW(pB0,14)};pw2=(u32x4){PKW(pB1,0),PKW(pB1,2),PKW(pB1,4),PKW(pB1,6)};pw3=(u32x4){PKW(pB1,8),PKW(pB1,10),PKW(pB1,12),PKW(pB1,14)};
    SBAR(); pv(o,vb0+sl_cur,PAF(0),PAF(1),PAF(2),PAF(3)); }
  #undef PKW
  #undef PAF
  #undef VFR
  #undef PIN
  #undef MX3
  #undef GAPA
  #undef GAPB
  #undef EX
  #undef VRD
  #undef KRD
  #undef STEP
  #undef ENDW
  {auto rr=__builtin_amdgcn_permlane32_swap(__float_as_uint(l_reg),__float_as_uint(l_reg),false,false);l_reg=__uint_as_float(rr[0])+__uint_as_float(rr[1]);}
  if(hi==0)wsf[32+r32]=l_reg;asm volatile("s_waitcnt lgkmcnt(0)":::"memory");
  float rli[16];
  #pragma unroll
  for(int r=0;r<16;++r)rli[r]=__builtin_amdgcn_rcpf(wsf[32+crow(r,hi)]);
  bf16*Ow=Ou+(long)(wid*QBLK)*DM;
  { bf16*stg=(bf16*)(shm+LDS_OST)+wid*2048;
    #pragma unroll
    for(int r=0;r<16;++r){const int orow=crow(r,hi);
      #pragma unroll
      for(int d0=0;d0<2;++d0)stg[orow*64+d0*32+r32]=__float2bfloat16(o[d0][r]*rli[r]);}
    asm volatile("s_waitcnt lgkmcnt(0)":::"memory");
    #pragma unroll
    for(int i=0;i<4;++i){const int row=i*8+(lane>>3),ch=lane&7; const u32x4 v=*(const u32x4*)(stg+row*64+ch*8); ATTN_STORE16(Ow+(long)row*DM+ch*8,v);} }
  asm volatile("s_waitcnt lgkmcnt(0)\n\ts_barrier":::"memory");
  #undef DMA_K
  #undef DMA_V
  #undef CMASK
  #undef START
  #undef RESC
  #undef ROT
}
constexpr int ATTN_LDS_BYTES=LDS_BYTES;
#undef SBAR
#undef WAIT_BAR
}
#define GAS __attribute__((address_space(1)))
#define LAS __attribute__((address_space(3)))
typedef unsigned short bf16;
typedef unsigned v4u __attribute__((ext_vector_type(4)));
typedef unsigned v2u __attribute__((ext_vector_type(2)));
typedef float f32x4 __attribute__((ext_vector_type(4)));
typedef short bf16x8 __attribute__((ext_vector_type(8)));
#define LDS_WAIT() asm volatile("s_waitcnt lgkmcnt(0)" ::: "memory")
__device__ __forceinline__ unsigned f2bf(float f) { unsigned u = __builtin_bit_cast(unsigned, f); return (u + 0x7fffu + ((u >> 16) & 1u)) >> 16; }
__device__ __forceinline__ unsigned pk2(float lo, float hi) { return f2bf(lo) | (f2bf(hi) << 16); }
__device__ __forceinline__ float bflo(unsigned w) { return __builtin_bit_cast(float, w << 16); }
__device__ __forceinline__ float bfhi(unsigned w) { return __builtin_bit_cast(float, w & 0xffff0000u); }

constexpr int NWAVES = 8, NTHR = 512;
constexpr int M_TOK = 32768, M_P = 16384, DMODEL = 1024, NQKV = 1536, FF = 2816, FF2 = 5632, SGI = 2048, SGI2 = 4096;
constexpr float EPS = 1e-6f;
constexpr size_t MiB = 1u << 20;
constexpr size_t WS_CTL = 0, CTL_BYTES = 1 * MiB;
constexpr size_t WS_WQKV = 1 * MiB, WS_WO = 4 * MiB, WS_WUP0 = 6 * MiB, WS_WDN0 = 17 * MiB, WS_WIN = 23 * MiB, WS_WOUT = 31 * MiB, WS_WUP1 = 35 * MiB, WS_WDN1 = 46 * MiB;
constexpr size_t WS_WS = 51 * MiB + 512 * 1024, WS_XN = 52 * MiB, WS_BIG = 116 * MiB, WS_END = 256 * MiB;
constexpr int LDS_BYTES = 163840;
constexpr size_t WS_BARW = 768 * 1024;
constexpr int LDSCTL_OFF = 131072, MISC_OFF = LDSCTL_OFF + 320;

__device__ __forceinline__ float wave_sum(float v) {
#pragma unroll
    for (int o = 1; o < 64; o <<= 1) v += __shfl_xor(v, o);
    return v;
}
__device__ __forceinline__ void p0_transpose_item(const float* W, const float* gain, int K, int N, bf16* WT, LAS float* scr, int item, int lane, bool ffn_up = false, bool qkv = false) {
    const int nblk = N / 32, kb = item / nblk, nb = item % nblk, k0 = 64 * kb, n0 = 32 * nb;
    int nd0 = n0; if (qkv && n0 < 1280) { const int head = n0 >> 6, bj = (n0 >> 5) & 1; nd0 = 256 * (head >> 2) + 128 * bj + 32 * (head & 3); }
    if (ffn_up) { const int x = n0 < FF ? n0 : n0 - FF; nd0 = 256 * (x / 128) + (x % 128) + (n0 < FF ? 0 : 128); }
    { float wv[32];
#pragma unroll
      for (int i = 0; i < 32; ++i) wv[i] = W[(size_t)(k0 + 2 * i + (lane >> 5)) * N + n0 + (lane & 31)];
      if (gain) {
#pragma unroll
          for (int i = 0; i < 32; ++i) wv[i] *= gain[k0 + 2 * i + (lane >> 5)]; }
#pragma unroll
      for (int i = 0; i < 32; ++i) scr[(2 * i + (lane >> 5)) * 33 + (lane & 31)] = wv[i]; }
    LDS_WAIT(); asm volatile("" ::: "memory");
    const int c = lane & 7;
#pragma unroll
    for (int j = 0; j < 4; ++j) { const int n = (lane >> 3) + 8 * j; const LAS float* s = scr + (8 * c) * 33 + n;
        v4u o; o.x = pk2(s[0 * 33], s[1 * 33]); o.y = pk2(s[2 * 33], s[3 * 33]); o.z = pk2(s[4 * 33], s[5 * 33]); o.w = pk2(s[6 * 33], s[7 * 33]);
        *(v4u*)(WT + (size_t)(nd0 + n) * K + k0 + 8 * c) = o; }
    LDS_WAIT(); asm volatile("" ::: "memory");
}

#define XB_TMO      128
#define XB_XCNT(j)  (256  + 64 * (j))
#define XB_XSUB(j)  (1280 + 64 * (j))
#define XB_XGEN(j)  (2304 + 64 * (j))
#define XB_TOP      3328
#define XB_TOPGEN   3392
#define XCD_BAR_WORDS 3456
#define XB_SPIN_CAP (1u << 18)

__device__ __forceinline__ unsigned xb_ld(unsigned* p)              { return __hip_atomic_load(p, __ATOMIC_RELAXED, __HIP_MEMORY_SCOPE_AGENT); }
__device__ __forceinline__ unsigned xb_add(unsigned* p, unsigned v) { return __hip_atomic_fetch_add(p, v, __ATOMIC_RELAXED, __HIP_MEMORY_SCOPE_AGENT); }
__device__ __forceinline__ unsigned xb_xcc_id() { return (unsigned)__builtin_amdgcn_s_getreg((3 << 11) | 20) & 0xFu; }
#define XB_SPIN(cond, bar) do { unsigned _sp = 0; while (cond) { __builtin_amdgcn_s_sleep(1); \
    if ((++_sp & 255u) == 0u) { if (xb_ld(&(bar)[XB_TMO])) break; if (_sp > XB_SPIN_CAP) { atomicAdd(&(bar)[XB_TMO], 1u); break; } } } } while (0)

struct XcdBarrier {
    unsigned* bar; unsigned x;
    volatile LAS unsigned* st;
};

__device__ __forceinline__ XcdBarrier xcd_barrier_post(unsigned* bar, volatile LAS unsigned* st) {
    XcdBarrier b; b.bar = bar; b.x = xb_xcc_id(); b.st = st;
    if (threadIdx.x == 0) (void)xb_add(&bar[XB_XCNT(b.x)], 1u);
    return b;
}
__device__ __forceinline__ void xcd_barrier_complete(unsigned* bar, unsigned x, unsigned& nloc, unsigned& nx) {
    const unsigned G = gridDim.x * gridDim.y * gridDim.z;
    unsigned sum, cnt, mine, sp = 0u;
    for (;;) {
        sum = 0u; cnt = 0u; mine = 0u;
#pragma unroll
        for (unsigned j = 0; j < 16; ++j) { const unsigned c = xb_ld(&bar[XB_XCNT(j)]); sum += c; cnt += (c > 0u) ? 1u : 0u; mine = (j == x) ? c : mine; }
        if (sum == G) break;
        __builtin_amdgcn_s_sleep(1);
        if ((++sp & 255u) == 0u) { if (xb_ld(&bar[XB_TMO])) break; if (sp > XB_SPIN_CAP) { atomicAdd(&bar[XB_TMO], 1u); break; } }
    }
    nloc = mine > 0u ? mine : 1u; nx = cnt > 0u ? cnt : 1u;
}

__device__ __forceinline__ void xcd_barrier(const XcdBarrier& b) {
    asm volatile("s_waitcnt vmcnt(0)" ::: "memory");
    __syncthreads();
    if (threadIdx.x == 0) {
        unsigned* bar = b.bar; unsigned bx_ = b.x; asm volatile("" : "+s"(bar), "+s"(bx_));
        __builtin_amdgcn_s_waitcnt(0);
        unsigned nloc = b.st[0], nx = b.st[1];
        if (nloc == 0u) { xcd_barrier_complete(bar, bx_, nloc, nx); b.st[0] = nloc; b.st[1] = nx; }
        const unsigned old = xb_add(&bar[XB_XSUB(bx_)], 1u);
        const unsigned gen = old / nloc;
        if (old + 1u == (gen + 1u) * nloc) {
            __builtin_amdgcn_fence(__ATOMIC_RELEASE, "agent");
            asm volatile("s_waitcnt vmcnt(0)" ::: "memory");
            const unsigned og = xb_add(&bar[XB_TOP], 1u);
            const unsigned tg = og / nx;
            if (og + 1u == (tg + 1u) * nx) xb_add(&bar[XB_TOPGEN], 1u);
            else XB_SPIN(xb_ld(&bar[XB_TOPGEN]) == tg, bar);
            __builtin_amdgcn_fence(__ATOMIC_ACQUIRE, "agent");
            xb_add(&bar[XB_XGEN(bx_)], 1u);
            asm volatile("s_waitcnt vmcnt(0)" ::: "memory");
        } else {
            XB_SPIN(xb_ld(&bar[XB_XGEN(bx_)]) == gen, bar);
            __builtin_amdgcn_fence(__ATOMIC_ACQUIRE, "agent");
            asm volatile("s_waitcnt vmcnt(0)" ::: "memory");
        }
    }
    __syncthreads();
}

struct Args { const float* in[17]; float* out; unsigned char* ws; };

__device__ __forceinline__ void p0_prologue(const Args& a, LAS unsigned char* lds, int gw, int NGW, int wave, int lane) {
    unsigned char* ws = a.ws;
    LAS float* scr = (LAS float*)(lds + wave * 16384);
    constexpr int I_QKV = 16 * 48, I_O = 16 * 32, I_UP = 16 * 176, I_DN = 44 * 32, I_IN = 16 * 128, I_OUT = 32 * 32;
    constexpr int NITEMS0 = I_QKV + I_O + I_UP + I_DN, NITEMS1 = I_UP + I_DN + I_IN + I_OUT;
    for (int it = gw; it < NITEMS0; it += NGW) {
        int r = it;
        if (r < I_QKV) { p0_transpose_item(a.in[4], a.in[2], 1024, NQKV, (bf16*)(ws + WS_WQKV), scr, r, lane, false, true); continue; } r -= I_QKV;
        if (r < I_O)   { p0_transpose_item(a.in[7], nullptr, 1024, 1024, (bf16*)(ws + WS_WO), scr, r, lane); continue; } r -= I_O;
        if (r < I_UP)  { p0_transpose_item(a.in[13], a.in[3], 1024, FF2, (bf16*)(ws + WS_WUP0), scr, r, lane, true); continue; } r -= I_UP;
        p0_transpose_item(a.in[16], nullptr, FF, 1024, (bf16*)(ws + WS_WDN0), scr, r, lane);
    }
    float* stat0 = (float*)(ws + WS_CTL);
    bf16* XN = (bf16*)(ws + WS_XN);
    for (int m0 = gw * 4; m0 < M_TOK; m0 += NGW * 4) {
        f32x4 v[4][4];
#pragma unroll
        for (int q = 0; q < 4; ++q) { const int m = m0 + q; const float* xrow = (m < M_P) ? a.in[0] + (size_t)m * 1024 : a.in[1] + (size_t)(m - M_P) * 1024;
            const f32x4* xr = (const f32x4*)xrow + lane;
#pragma unroll
            for (int j = 0; j < 4; ++j) v[q][j] = xr[64 * j]; }
#pragma unroll
        for (int q = 0; q < 4; ++q) { const int m = m0 + q; float s = 0.f;
#pragma unroll
            for (int j = 0; j < 4; ++j) s += (v[q][j].x * v[q][j].x + v[q][j].y * v[q][j].y) + (v[q][j].z * v[q][j].z + v[q][j].w * v[q][j].w);
            s = wave_sum(s);
            v2u* o8 = (v2u*)(XN + (size_t)m * 1024) + lane;
#pragma unroll
            for (int j = 0; j < 4; ++j) { v2u w; w.x = pk2(v[q][j].x, v[q][j].y); w.y = pk2(v[q][j].z, v[q][j].w); o8[64 * j] = w; }
            if (lane == 0) stat0[m] = s; }
    }
}

__device__ __forceinline__ void p0_layer1_weights(const Args& a, LAS unsigned char* lds, int part, int w, int nw, int wave, int lane) {
    asm volatile("" : "+v"(lane));
    asm volatile("" : "+s"(nw), "+s"(w));
    unsigned char* ws = a.ws;
    LAS float* scr = (LAS float*)(lds + wave * 16384);
    constexpr int I_UP = 16 * 176, I_DN = 44 * 32, I_IN = 16 * 128, I_OUT = 32 * 32, NITEMS1 = I_UP + I_DN + I_IN + I_OUT, HALFI = NITEMS1 / 2;
#pragma unroll 1
    for (int it = part * HALFI + w; it < (part + 1) * HALFI; it += nw) {
        int r = it;
        if (r < I_UP)  { p0_transpose_item(a.in[13] + (size_t)1024 * FF2, a.in[3] + 1024, 1024, FF2, (bf16*)(ws + WS_WUP1), scr, r, lane, true); continue; } r -= I_UP;
        if (r < I_DN)  { p0_transpose_item(a.in[16] + (size_t)FF * 1024, nullptr, FF, 1024, (bf16*)(ws + WS_WDN1), scr, r, lane); continue; } r -= I_DN;
        if (r < I_IN)  { p0_transpose_item(a.in[8], a.in[2] + 1024, 1024, SGI2, (bf16*)(ws + WS_WIN), scr, r, lane); continue; } r -= I_IN;
        p0_transpose_item(a.in[12], nullptr, SGI, 1024, (bf16*)(ws + WS_WOUT), scr, r, lane);
    }
    if (part == 0) { const float* s = a.in[10]; unsigned* d = (unsigned*)(ws + WS_WS);
      for (int i = w * 64 + lane; i < 8 * 128 * 128 / 2; i += nw * 64) d[i] = pk2(s[2 * i], s[2 * i + 1]); }
}

__device__ __forceinline__ void rope_phase(bf16* QKV, const float* qg, const float* kg, int gw, int NGW, int lane) {
    const int half = lane >> 5, j = lane & 31, i = j & 15, da = (j >> 4) * 32 + i, db = da + 16;
    const float inv_freq = __builtin_amdgcn_exp2f(-(float)i * 0.830482024f);
    const float qga = qg[da], qgb = qg[db], kga = kg[da], kgb = kg[db];
    for (int r = gw; r < M_TOK; r += NGW) {
        const int t = (r < M_P) ? (r & 8191) : (r & 2047);
        const float pos = (float)((j < 16) ? (t >> 6) : (t & 63));
        float rev = pos * inv_freq * 0.15915494309189535f; rev -= floorf(rev);
        const float sn = __builtin_amdgcn_sinf(rev), cs = __builtin_amdgcn_cosf(rev);
        bf16* row = QKV + (size_t)r * NQKV;
#pragma unroll
        for (int it = 0; it < 10; ++it) {
            bf16* p = row + (2 * it + half) * 64;
            float x = __builtin_bit_cast(float, (unsigned)p[da] << 16), y = __builtin_bit_cast(float, (unsigned)p[db] << 16);
            float ss = x * x + y * y;
#pragma unroll
            for (int o = 1; o < 32; o <<= 1) ss += __shfl_xor(ss, o);
            const float rn = __builtin_amdgcn_rsqf(ss * (1.0f / 64.0f) + EPS);
            const bool isq = it < 8;
            x *= rn * (isq ? qga : kga); y *= rn * (isq ? qgb : kgb);
            float ox = x * cs - y * sn, oy = y * cs + x * sn;
            if (isq) { ox *= attn_body::C2; oy *= attn_body::C2; }
            p[da] = (bf16)f2bf(ox); p[db] = (bf16)f2bf(oy);
        }
    }
}

__device__ __forceinline__ void unpack8(const v4u w, float (&f)[8]) { f[0] = bflo(w.x); f[1] = bfhi(w.x); f[2] = bflo(w.y); f[3] = bfhi(w.y); f[4] = bflo(w.z); f[5] = bfhi(w.z); f[6] = bflo(w.w); f[7] = bfhi(w.w); }
__device__ __forceinline__ void ffn_fixup(const bf16* HALO, bf16* ACT, int pm, int grow_h0, const float* cw, const float* cb) {
    int tid = threadIdx.x; asm volatile("" : "+v"(tid));
    constexpr int NCG = FF / 8;
#pragma unroll 1
    for (int it = tid; it < 8 * NCG; it += NTHR) {
        const int cgi = it % NCG, br = it / NCG, blk = pm * 4 + (br >> 1); const bool bot = (br & 1) != 0;
        const int a0 = cgi * 8, ng = 256 * (a0 >> 7) + (a0 & 127);
        const int lrow = blk * 64 + (bot ? 63 : 0), grow = grow_h0 + lrow, L = (grow < M_P) ? 8192 : 2048;
        const bool zp = !bot && ((grow & (L - 1)) == 0), zn = bot && (((grow + 1) & (L - 1)) == 0);
        const bf16* hb = HALO + (size_t)blk * 4 * FF2 + ng;
        const bf16* pp = bot ? hb + 2 * FF2 : hb - FF2; const bf16* pc = bot ? hb + 3 * FF2 : hb; const bf16* pn_ = bot ? hb + 4 * FF2 : hb + FF2;
        float pg[8], pu[8], cg_[8], cu[8], ng_[8], nu[8];
        if (zp) {
#pragma unroll
            for (int e = 0; e < 8; ++e) { pg[e] = 0.f; pu[e] = 0.f; } }
        else { unpack8(*(const v4u*)pp, pg); unpack8(*(const v4u*)(pp + 128), pu); }
        unpack8(*(const v4u*)pc, cg_); unpack8(*(const v4u*)(pc + 128), cu);
        if (zn) {
#pragma unroll
            for (int e = 0; e < 8; ++e) { ng_[e] = 0.f; nu[e] = 0.f; } }
        else { unpack8(*(const v4u*)pn_, ng_); unpack8(*(const v4u*)(pn_ + 128), nu); }
        float o[8];
#pragma unroll
        for (int h = 0; h < 2; ++h) {
            f32x4 wg[3], wu[3];
#pragma unroll
            for (int k = 0; k < 3; ++k) { wg[k] = *(const f32x4*)(cw + k * FF2 + a0 + 4 * h); wu[k] = *(const f32x4*)(cw + k * FF2 + FF + a0 + 4 * h); }
            const f32x4 bg = *(const f32x4*)(cb + a0 + 4 * h), bu = *(const f32x4*)(cb + FF + a0 + 4 * h);
#pragma unroll
            for (int j = 0; j < 4; ++j) { const int e = 4 * h + j;
                const float g = pg[e] * wg[0][j] + cg_[e] * wg[1][j] + ng_[e] * wg[2][j] + bg[j];
                const float u = pu[e] * wu[0][j] + cu[e] * wu[1][j] + nu[e] * wu[2][j] + bu[j];
                o[e] = g * __builtin_amdgcn_rcpf(1.0f + __builtin_amdgcn_exp2f(-1.4426950408889634f * g)) * u; }
        }
        v4u w; w.x = pk2(o[0], o[1]); w.y = pk2(o[2], o[3]); w.z = pk2(o[4], o[5]); w.w = pk2(o[6], o[7]);
        *(v4u*)(ACT + (size_t)lrow * FF + a0) = w;
    }
}

constexpr int SG_PITCH = 272;
__device__ __forceinline__ void sgu_prefetch_v(const bf16* Z, int rloc0, int grow0, int g, const float* vgain, const float* vstat, int tid, v4u (&v)[8], float (&st)[8], f32x4 (&vg)[2]) {
    const int db = tid & 31, qb = tid >> 5, d0 = 8 * db, q0 = 8 * qb;
#pragma unroll
    for (int i = 0; i < 8; ++i) { v[i] = *(const v4u*)(Z + (size_t)(rloc0 + q0 + i) * SGI2 + SGI + 256 * g + d0); st[i] = vstat[grow0 + q0 + i]; }
    vg[0] = *(const f32x4*)(vgain + 256 * g + d0); vg[1] = *(const f32x4*)(vgain + 256 * g + d0 + 4);
}
__device__ __forceinline__ void sgu_prefetch_u(const bf16* Z, int rloc0, int g, int tid, v4u (&uw)[8]) {
#pragma unroll
    for (int i = 0; i < 8; ++i) uw[i] = *(const v4u*)(Z + (size_t)(rloc0 + (tid >> 5) + 16 * i) * SGI2 + 256 * g + 8 * (tid & 31));
}
__device__ __forceinline__ void sgu_phase(LAS unsigned char* lds, bf16* Z, int r0, const bf16* wsb, const float* bs, const float* vgain, const float* vstat, int vcu, int G) {
    int tid_ = threadIdx.x; asm volatile("" : "+v"(tid_));
    const int tid = tid_, lane = tid & 63, wid = __builtin_amdgcn_readfirstlane(tid >> 6), fr = lane & 15, fq = lane >> 4;
    LAS unsigned char* ldsA = lds + 256 * SG_PITCH;
    v4u v[8]; float st[8]; v4u uw[8]; f32x4 vg[2];
    int u = vcu, g_staged = -1;
    constexpr int SP = 528;
    if (u < 1024) sgu_prefetch_v(Z, (u >> 3) * 128, r0 + (u >> 3) * 128, u & 7, vgain, vstat, tid, v, st, vg);
#pragma unroll 1
    for (; u < 1024; u += G) {
        const int g = u & 7, rloc0 = (u >> 3) * 128;
        sgu_prefetch_u(Z, rloc0, g, tid, uw);
        __syncthreads();
        {
            const int db = tid & 31, qb = tid >> 5, d0 = 8 * db;
            float rs[8];
#pragma unroll
            for (int i = 0; i < 8; ++i) rs[i] = __builtin_amdgcn_rsqf(st[i] * (1.0f / 2048.0f) + EPS);
#pragma unroll
            for (int kh = 0; kh < 2; ++kh) {
                float val[8][4];
#pragma unroll
                for (int i = 0; i < 8; ++i) { const unsigned w0 = kh ? v[i].z : v[i].x, w1 = kh ? v[i].w : v[i].y;
                    val[i][0] = bflo(w0) * rs[i] * vg[kh][0]; val[i][1] = bfhi(w0) * rs[i] * vg[kh][1]; val[i][2] = bflo(w1) * rs[i] * vg[kh][2]; val[i][3] = bfhi(w1) * rs[i] * vg[kh][3]; }
#pragma unroll
                for (int k = 0; k < 4; ++k) {
                    v4u o; o.x = pg8::cvt_pk_bf16(val[0][k], val[1][k]); o.y = pg8::cvt_pk_bf16(val[2][k], val[3][k]); o.z = pg8::cvt_pk_bf16(val[4][k], val[5][k]); o.w = pg8::cvt_pk_bf16(val[6][k], val[7][k]);
                    const int d = d0 + 4 * kh + k;
                    *(LAS v4u*)(lds + d * SG_PITCH + ((qb ^ (db & 15)) << 4)) = o;
                }
            }
            if (g != g_staged) { g_staged = g;
#pragma unroll
                for (int i = 0; i < 4; ++i) { const int e = tid + NTHR * i, p = e >> 4, ch = e & 15; *(LAS v4u*)(ldsA + p * SG_PITCH + (ch << 4)) = *(const v4u*)(wsb + (size_t)g * 16384 + (size_t)e * 8); } }
        }
        __syncthreads();
        { const int un = u + G; if (un < 1024) sgu_prefetch_v(Z, (un >> 3) * 128, r0 + (un >> 3) * 128, un & 7, vgain, vstat, tid, v, st, vg); }
        f32x4 acc[8][2];
#pragma unroll
        for (int mt = 0; mt < 8; ++mt)
#pragma unroll
            for (int nt = 0; nt < 2; ++nt) acc[mt][nt] = (f32x4){0.f, 0.f, 0.f, 0.f};
#pragma unroll
        for (int ks = 0; ks < 4; ++ks) {
            bf16x8 bfr[2];
#pragma unroll
            for (int nt = 0; nt < 2; ++nt) { const int d = 32 * wid + 16 * nt + fr; bfr[nt] = *(const LAS bf16x8*)(lds + d * SG_PITCH + ((((4 * ks + fq) ^ ((d >> 3) & 15))) << 4)); }
#pragma unroll
            for (int mt = 0; mt < 8; ++mt) {
                const bf16x8 afr = *(const LAS bf16x8*)(ldsA + (16 * mt + fr) * SG_PITCH + ((4 * ks + fq) << 4));
#pragma unroll
                for (int nt = 0; nt < 2; ++nt) acc[mt][nt] = __builtin_amdgcn_mfma_f32_16x16x32_bf16(bfr[nt], afr, acc[mt][nt], 0, 0, 0);
            }
        }
        __syncthreads();
#pragma unroll
        for (int mt = 0; mt < 8; ++mt) {
            const int p = 16 * mt + fr; const float b1 = bs[g * 128 + p];
#pragma unroll
            for (int nt = 0; nt < 2; ++nt) { const f32x4 sv = acc[mt][nt]; v2u o; o.x = pg8::cvt_pk_bf16(sv[0] + b1, sv[1] + b1); o.y = pg8::cvt_pk_bf16(sv[2] + b1, sv[3] + b1);
                *(LAS v2u*)(lds + p * SP + (32 * wid + 16 * nt + 4 * fq) * 2) = o; }
        }
        __syncthreads();
#pragma unroll
        for (int i = 0; i < 8; ++i) {
            const int row = (tid >> 5) + 16 * i; const v4u sw = *(const LAS v4u*)(lds + row * SP + (tid & 31) * 16); const v4u u4 = uw[i];
            v4u o; o.x = pg8::cvt_pk_bf16(bflo(u4.x) * bflo(sw.x), bfhi(u4.x) * bfhi(sw.x)); o.y = pg8::cvt_pk_bf16(bflo(u4.y) * bflo(sw.y), bfhi(u4.y) * bfhi(sw.y));
            o.z = pg8::cvt_pk_bf16(bflo(u4.z) * bflo(sw.z), bfhi(u4.z) * bfhi(sw.z)); o.w = pg8::cvt_pk_bf16(bflo(u4.w) * bflo(sw.w), bfhi(u4.w) * bfhi(sw.w));
            *(v4u*)(Z + (size_t)(rloc0 + row) * SGI2 + 256 * g + 8 * (tid & 31)) = o;
        }
    }
}

__global__ void __launch_bounds__(NTHR, 2) mk_fwd(Args a) {
    extern __shared__ __attribute__((aligned(16))) unsigned char lds_raw[];
    cg::grid_group grid = cg::this_grid();
    LAS unsigned char* lds = (LAS unsigned char*)lds_raw;
    const int tid = threadIdx.x, lane = tid & 63, wave = __builtin_amdgcn_readfirstlane(tid >> 6);
    const int G = gridDim.x, bx = blockIdx.x, vcu = (G % 8 == 0) ? (bx % 8) * (G / 8) + bx / 8 : bx;
    const int gw = vcu * NWAVES + wave, NGW = G * NWAVES;
    unsigned char* ws = a.ws;
    float* stat0 = (float*)(ws + WS_CTL); float* stat1 = stat0 + M_TOK; float* stat2 = stat1 + M_TOK; float* stat3 = stat2 + M_TOK; float* stat4 = stat3 + M_TOK;
    bf16* XN = (bf16*)(ws + WS_XN); bf16* BIG = (bf16*)(ws + WS_BIG);
    float* out = a.out;
    for (int u = tid; u < (LDS_BYTES - LDSCTL_OFF) / 4; u += NTHR) ((LAS unsigned*)(lds + LDSCTL_OFF))[u] = 0u;
    __syncthreads();
    XcdBarrier bar = xcd_barrier_post((unsigned*)(ws + WS_BARW), (volatile LAS unsigned*)(lds + MISC_OFF) + 8);
#define GSYNC() xcd_barrier(bar)

    p0_prologue(a, lds, gw, NGW, wave, lane);
    if (a.out == nullptr) grid.sync();
    GSYNC();
    { pg8::Gemm g{XN, (const bf16*)(ws + WS_WQKV), M_TOK, NQKV, 1024, 1024, 1024}; pg8::StaticOrder S; S.init(M_TOK, NQKV, G, bx);
      pg8::EpiQKV E{BIG, stat0, a.in[5], a.in[6]};
      pg8::gemm_phase<pg8::EpiQKV, pg8::StaticOrder, true, true>(lds, g, S, E); }
    GSYNC();
    { const attn_body::bf16* QKV = (const attn_body::bf16*)BIG;
      float mq = __builtin_fabsf(a.in[5][lane]), mk = __builtin_fabsf(a.in[6][lane]);
#pragma unroll
      for (int o = 1; o < 64; o <<= 1) { mq = __builtin_fmaxf(mq, __shfl_xor(mq, o)); mk = __builtin_fmaxf(mk, __shfl_xor(mk, o)); }
      const int nomax = __builtin_amdgcn_readfirstlane((mq * mk < 4.0f) ? 1 : 0);
#define ATT_LOOPS(NM) \
      for (int k = vcu * 4; k < 1024; k += G * 4) \
          for (int i = 0; i < 4; ++i) { const int u = k + i, bh = u >> 5, qb = u & 31, b = bh >> 4, h = bh & 15; const size_t row0 = (size_t)b * 8192; \
              const attn_body::bf16* Qu = QKV + (row0 + qb * 256) * NQKV + h * 64; const attn_body::bf16* Kh = QKV + row0 * NQKV + 1024 + (h >> 2) * 64; \
              attn_body::attn_unit<8, NM>(Qu, Kh, Kh + 256, (attn_body::bf16*)Qu, 128, (char*)lds_raw); } \
      for (int k = vcu * 4; k < 1024; k += G * 4) \
          for (int i = 0; i < 4; ++i) { const int u = k + i, bh = u >> 3, qb = u & 7, b = bh >> 4, h = bh & 15; const size_t row0 = (size_t)M_P + (size_t)b * 2048; \
              const attn_body::bf16* Qu = QKV + (row0 + qb * 256) * NQKV + h * 64; const attn_body::bf16* Kh = QKV + row0 * NQKV + 1024 + (h >> 2) * 64; \
              attn_body::attn_unit<8, NM>(Qu, Kh, Kh + 256, (attn_body::bf16*)Qu, 32, (char*)lds_raw); }
      if (nomax) { ATT_LOOPS(true) } else { ATT_LOOPS(false) }
#undef ATT_LOOPS
    }
    GSYNC();
    { pg8::Gemm g{BIG, (const bf16*)(ws + WS_WO), M_TOK, 1024, 1024, NQKV, 1024}; pg8::StaticOrder S; S.init(M_TOK, 1024, G, bx);
      pg8::EpiRes E{nullptr, nullptr, 0x7fffffff, nullptr, XN, stat1, 0, XN};
      pg8::gemm_phase<pg8::EpiRes, pg8::StaticOrder, true, true>(lds, g, S, E); }
    GSYNC();
#pragma unroll 1
    for (int layer = 0; layer < 2; ++layer) {
        if (layer == 1) {
#pragma unroll 1
            for (int hf = 0; hf < 2; ++hf) {
                const int r0 = hf * 16384;
                { pg8::Gemm g{XN + (size_t)r0 * 1024, (const bf16*)(ws + WS_WIN), 16384, SGI2, 1024, 1024, 1024}; pg8::StaticOrder S; S.init(16384, SGI2, G, bx);
                  pg8::EpiBf16S<2> E{BIG, SGI2, stat2, 1.0f / 1024.0f, r0, stat3, SGI};
                  pg8::gemm_phase<pg8::EpiBf16S<2>, pg8::StaticOrder, true, true>(lds, g, S, E); }
                GSYNC();
                sgu_phase(lds, BIG, r0, (const bf16*)(ws + WS_WS), a.in[11], a.in[9], stat3, vcu, G);
                GSYNC();
                { pg8::Gemm g{BIG, (const bf16*)(ws + WS_WOUT), 16384, 1024, SGI, SGI2, SGI}; pg8::StaticOrder S; S.init(16384, 1024, G, bx);
                  pg8::EpiRes E{nullptr, nullptr, 0x7fffffff, nullptr, XN, stat4, r0, XN};
                  pg8::gemm_phase<pg8::EpiRes, pg8::StaticOrder, true, true>(lds, g, S, E); }
                GSYNC();
            }
        }
        const bf16* Wup = (const bf16*)(ws + (layer ? WS_WUP1 : WS_WUP0)); const bf16* Wdn = (const bf16*)(ws + (layer ? WS_WDN1 : WS_WDN0));
        const float* st_in = layer ? stat4 : stat1;
        const float* cw = a.in[14] + (size_t)layer * 3 * FF2; const float* cb = a.in[15] + (size_t)layer * FF2;
        bf16* ACT = BIG; bf16* HALO = BIG + (size_t)16384 * FF;
#pragma unroll 1
        for (int hf = 0; hf < 2; ++hf) {
            const int r0 = hf * 16384;
            { pg8::Gemm g{XN + (size_t)r0 * 1024, Wup, 16384, FF2, 1024, 1024, 1024}; pg8::StaticOrder S; S.init(16384, FF2, G, bx);
              pg8::EpiConv E{ACT, HALO, st_in, r0, cw, cb};
              pg8::gemm_phase<pg8::EpiConv, pg8::StaticOrder, true, true>(lds, g, S, E); }
            if (layer == 0) {
                const bool spare = (G == 256) ? (bx >= 128) : true;
                if (spare) { const int nb = (G == 256) ? 128 : G, bi = (G == 256) ? bx - 128 : bx; p0_layer1_weights(a, lds, hf, bi * NWAVES + wave, nb * NWAVES, wave, lane); }
            }
            GSYNC();
            { pg8::Gemm g{ACT, Wdn, 16384, 1024, FF, FF, FF}; pg8::StaticOrder S; S.init(16384, 1024, G, bx);
              { pg8::Unit uu; for (int i = 0; S.next(i, uu); ++i) ffn_fixup(HALO, ACT, uu.pm, r0, cw, cb); }
              asm volatile("s_waitcnt vmcnt(0)" ::: "memory"); __syncthreads();
              if (layer == 0) { pg8::EpiRes E{nullptr, nullptr, 0x7fffffff, nullptr, XN, stat2, r0, XN};
                  pg8::gemm_phase<pg8::EpiRes, pg8::StaticOrder, true, true>(lds, g, S, E); }
              else { pg8::EpiResF E{nullptr, nullptr, 0x7fffffff, out, nullptr, nullptr, r0, XN};
                  pg8::gemm_phase<pg8::EpiResF, pg8::StaticOrder, true, true>(lds, g, S, E); } }
            if (!(layer == 1 && hf == 1)) GSYNC();
        }
    }
}

extern "C" void kernel_launch(void* const* d_in, const int* in_sizes, int n_in, void* d_out, int out_size, void* d_ws, size_t ws_size, hipStream_t stream) {
    static int grid = 0;
    if (grid == 0) {
        if (n_in != 17 || out_size != M_TOK * 1024 || ws_size < WS_END) { fprintf(stderr, "kernel_launch: unexpected shapes (n_in %d out %d ws %zu)\n", n_in, out_size, ws_size); grid = -1; return; }
        int dev = 0, cus = 0, per_cu = 0;
        if (hipGetDevice(&dev) != hipSuccess || hipDeviceGetAttribute(&cus, hipDeviceAttributeMultiprocessorCount, dev) != hipSuccess) { grid = -1; return; }
        if (hipFuncSetAttribute((const void*)mk_fwd, hipFuncAttributeMaxDynamicSharedMemorySize, LDS_BYTES) != hipSuccess) { fprintf(stderr, "kernel_launch: hipFuncSetAttribute failed\n"); grid = -1; return; }
        if (hipOccupancyMaxActiveBlocksPerMultiprocessor(&per_cu, (const void*)mk_fwd, NTHR, LDS_BYTES) != hipSuccess || per_cu < 1) { fprintf(stderr, "kernel_launch: occupancy query says %d\n", per_cu); per_cu = 1; }
        (void)hipGetLastError();
        grid = cus;
    }
    if (grid < 0) return;
    (void)hipMemsetAsync((char*)d_ws + WS_CTL, 0, CTL_BYTES, stream);
    Args a{};
    for (int i = 0; i < 17; ++i) a.in[i] = (const float*)d_in[i];
    a.out = (float*)d_out; a.ws = (unsigned char*)d_ws;
    void* args[] = {&a};
    hipError_t e = hipLaunchCooperativeKernel((const void*)mk_fwd, dim3(grid), dim3(NTHR), args, LDS_BYTES, stream);
    if (e != hipSuccess) fprintf(stderr, "kernel_launch: cooperative launch failed: %s (grid %d)\n", hipGetErrorString(e), grid);
}
```
